# Optimizing an MI355X kernel written in HIP

```python
import jax, jax.numpy as jnp
from jax import lax
import numpy as np

D_MODEL = 1024
BATCH = 8
SEQ = 4096
DEPTH = 4

N_MIXERS = 2
CHUNK = 128
GMLP_WIDTH = D_MODEL
GMLP_GROUPS = 8
GMLP_GROUP_DIM = GMLP_WIDTH // GMLP_GROUPS
RWKV_HEAD = 64
RWKV_HEADS = D_MODEL // RWKV_HEAD
DECAY_LORA = 64
AAA_LORA = 64
MV_LORA = 32
GATE_LORA = 160
D_FF = 4 * D_MODEL
N_A = (DEPTH + 1) // 2
N_B = DEPTH // 2
N_VRES = max(N_B - 1, 0)
ALPHA = (2.0 * DEPTH) ** 0.25
BETA = (8.0 * DEPTH) ** -0.25
LN_EPS = 1e-5
GN_EPS = 64e-5

kernel_name = 'hybrid_gmlp_rwkv7_deepnorm_trunk'


def _layer_norm(x, g, b, eps):
    xf = x.astype(jnp.float32)
    mean = jnp.mean(xf, axis=-1, keepdims=True)
    var = jnp.mean(jnp.square(xf - mean), axis=-1, keepdims=True)
    y = (xf - mean) * lax.rsqrt(var + eps)
    return (y * g.astype(jnp.float32) + b.astype(jnp.float32)).astype(x.dtype)


def _gmlp_mixer(x, w_in, vn_g, vn_b, ws, bs, w_out):
    B, S, _ = x.shape
    z = jax.nn.gelu(x @ w_in, approximate=False)
    u, v = jnp.split(z, 2, axis=-1)
    v = _layer_norm(v, vn_g, vn_b, LN_EPS)
    v = v.reshape(B, S // CHUNK, CHUNK, GMLP_GROUPS, GMLP_GROUP_DIM)
    causal = jnp.tril(jnp.ones((CHUNK, CHUNK), dtype=bool))
    ws_c = jnp.where(causal[None], ws, jnp.zeros_like(ws)).astype(v.dtype)
    mixed = jnp.einsum('gts,bcsgd->bctgd', ws_c, v) + bs.T[None, None, :, :, None]
    gated = u * mixed.reshape(B, S, GMLP_WIDTH)
    return gated @ w_out


def _token_shift(x):
    return jnp.pad(x, ((0, 0), (1, 0), (0, 0)))[:, :-1, :]


def _wkv7(r, decay, k, v, kk, b):
    xs = tuple(jnp.moveaxis(t.astype(jnp.float32), 1, 0) for t in (r, decay, k, v, kk, b))
    Bsz, _, H, N = r.shape

    def step(state, inp):
        r_t, w_t, k_t, v_t, kk_t, b_t = inp
        sa = jnp.einsum('bhij,bhj->bhi', state, -kk_t)
        state = (state * w_t[:, :, None, :] + sa[..., None] * b_t[:, :, None, :]
                 + v_t[..., None] * k_t[:, :, None, :])
        y = jnp.einsum('bhij,bhj->bhi', state, r_t)
        return state, y

    s0 = jnp.zeros((Bsz, H, N, N), jnp.float32)
    _, ys = lax.scan(step, s0, xs)
    return jnp.moveaxis(ys, 0, 1)


def _rwkv7_mixer(x, v_first, mu, w_rkv, w0, w1, w2, a0, a1, a2, g1, g2,
                 k_k, k_a, r_k, gn_g, gn_b, w_o, vres):
    B, S, D = x.shape
    H, N = RWKV_HEADS, RWKV_HEAD
    xx = _token_shift(x) - x
    xr, xw, xk, xv, xa, xg = (x + xx * mu[i] for i in range(6))
    r = xr @ w_rkv[0]
    k = xk @ w_rkv[1]
    v = xv @ w_rkv[2]
    w_log = -jax.nn.softplus(-(w0 + jnp.tanh(xw @ w1) @ w2)) - 0.5
    decay = jnp.exp(-jnp.exp(w_log.astype(jnp.float32)))
    a = jax.nn.sigmoid(a0 + (xa @ a1) @ a2)
    g = jax.nn.sigmoid(xg @ g1) @ g2
    if vres is None:
        v_first = v
    else:
        v0, v1, v2 = vres
        v = v + (v_first - v) * jax.nn.sigmoid(v0 + (xv @ v1) @ v2)
    kk = (k * k_k).reshape(B, S, H, N).astype(jnp.float32)
    kk = kk / jnp.maximum(jnp.sqrt(jnp.sum(kk * kk, axis=-1, keepdims=True)), 1e-12)
    k = k * (1.0 + (a - 1.0) * k_a)
    rh = r.reshape(B, S, H, N)
    kh = k.reshape(B, S, H, N)
    vh = v.reshape(B, S, H, N)
    ah = a.reshape(B, S, H, N).astype(jnp.float32)
    y = _wkv7(rh, decay.reshape(B, S, H, N), kh, vh, kk, kk * ah)
    mean = jnp.mean(y, axis=-1, keepdims=True)
    var = jnp.mean(jnp.square(y - mean), axis=-1, keepdims=True)
    y = ((y - mean) * lax.rsqrt(var + GN_EPS)).reshape(B, S, D)
    y = (y * gn_g.astype(jnp.float32) + gn_b.astype(jnp.float32)).astype(x.dtype)
    bonus = (jnp.sum(rh * kh * r_k, axis=-1, keepdims=True) * vh).reshape(B, S, D)
    return ((y + bonus) * g) @ w_o, v_first


def setup_inputs(seed: int = 0) -> dict:
    key = jax.random.key(seed)
    ks = iter(jax.random.split(key, 40))

    def nrm(shape, scale):
        return jax.random.normal(next(ks), shape, jnp.float32) * scale

    lin = jnp.arange(D_MODEL, dtype=jnp.float32) / (D_MODEL - 1)
    ratio = jnp.arange(N_B, dtype=jnp.float32) / max(N_B - 1, 1)
    decay_speed = -7.0 + 5.0 * lin[None, :] ** (0.85 + ratio[:, None] ** 0.5)
    return {
        'x': nrm((BATCH, SEQ, D_MODEL), 1.0),
        'ln1_g': 1.0 + nrm((DEPTH, D_MODEL), 0.02),
        'ln1_b': nrm((DEPTH, D_MODEL), 0.02),
        'ln2_g': 1.0 + nrm((DEPTH, D_MODEL), 0.02),
        'ln2_b': nrm((DEPTH, D_MODEL), 0.02),
        'ffn_w1': nrm((DEPTH, D_MODEL, D_FF), D_MODEL ** -0.5),
        'ffn_w2': nrm((DEPTH, D_FF, D_MODEL), D_FF ** -0.5 * BETA),
        'gm_w_in': nrm((N_A, D_MODEL, 2 * GMLP_WIDTH), D_MODEL ** -0.5),
        'gm_vn_g': 1.0 + nrm((N_A, GMLP_WIDTH), 0.02),
        'gm_vn_b': nrm((N_A, GMLP_WIDTH), 0.02),
        'gm_ws': nrm((N_A, GMLP_GROUPS, CHUNK, CHUNK), CHUNK ** -0.5),
        'gm_bs': 1.0 + nrm((N_A, GMLP_GROUPS, CHUNK), 0.1),
        'gm_w_out': nrm((N_A, GMLP_WIDTH, D_MODEL), GMLP_WIDTH ** -0.5 * BETA),
        'rw_mu': jax.random.uniform(next(ks), (N_B, 6, D_MODEL), jnp.float32),
        'rw_w_rkv': nrm((N_B, 3, D_MODEL, D_MODEL), D_MODEL ** -0.5),
        'rw_w0': decay_speed + 0.5 + nrm((N_B, D_MODEL), 0.1),
        'rw_w1': nrm((N_B, D_MODEL, DECAY_LORA), D_MODEL ** -0.5),
        'rw_w2': nrm((N_B, DECAY_LORA, D_MODEL), 0.1 * DECAY_LORA ** -0.5),
        'rw_a0': nrm((N_B, D_MODEL), 0.1),
        'rw_a1': nrm((N_B, D_MODEL, AAA_LORA), D_MODEL ** -0.5),
        'rw_a2': nrm((N_B, AAA_LORA, D_MODEL), 0.1 * AAA_LORA ** -0.5),
        'rw_g1': nrm((N_B, D_MODEL, GATE_LORA), D_MODEL ** -0.5),
        'rw_g2': nrm((N_B, GATE_LORA, D_MODEL), GATE_LORA ** -0.5),
        'rw_k_k': 0.85 + nrm((N_B, D_MODEL), 0.05),
        'rw_k_a': 1.0 + nrm((N_B, D_MODEL), 0.05),
        'rw_r_k': -0.04 + nrm((N_B, RWKV_HEADS, RWKV_HEAD), 0.1),
        'rw_gn_g': 1.0 + nrm((N_B, D_MODEL), 0.02),
        'rw_gn_b': nrm((N_B, D_MODEL), 0.02),
        'rw_w_o': nrm((N_B, D_MODEL, D_MODEL), D_MODEL ** -0.5 * BETA),
        'rw_v0': 1.0 + nrm((N_VRES, D_MODEL), 0.1),
        'rw_v1': nrm((N_VRES, D_MODEL, MV_LORA), D_MODEL ** -0.5),
        'rw_v2': nrm((N_VRES, MV_LORA, D_MODEL), 0.1 * MV_LORA ** -0.5),
    }


def reference(x, ln1_g, ln1_b, ln2_g, ln2_b, ffn_w1, ffn_w2,
              gm_w_in, gm_vn_g, gm_vn_b, gm_ws, gm_bs, gm_w_out,
              rw_mu, rw_w_rkv, rw_w0, rw_w1, rw_w2, rw_a0, rw_a1, rw_a2,
              rw_g1, rw_g2, rw_k_k, rw_k_a, rw_r_k, rw_gn_g, rw_gn_b, rw_w_o,
              rw_v0, rw_v1, rw_v2):
    h = x
    v_first = None
    for i in range(DEPTH):
        j = i // N_MIXERS
        if i % N_MIXERS == 0:
            mix = _gmlp_mixer(h, gm_w_in[j], gm_vn_g[j], gm_vn_b[j], gm_ws[j],
                              gm_bs[j], gm_w_out[j])
        else:
            vres = None if j == 0 else (rw_v0[j - 1], rw_v1[j - 1], rw_v2[j - 1])
            mix, v_first = _rwkv7_mixer(h, v_first, rw_mu[j], rw_w_rkv[j], rw_w0[j],
                                        rw_w1[j], rw_w2[j], rw_a0[j], rw_a1[j], rw_a2[j],
                                        rw_g1[j], rw_g2[j], rw_k_k[j], rw_k_a[j],
                                        rw_r_k[j], rw_gn_g[j], rw_gn_b[j], rw_w_o[j], vres)
        h = _layer_norm(ALPHA * h + mix, ln1_g[i], ln1_b[i], LN_EPS)
        f = jnp.square(jax.nn.relu(h @ ffn_w1[i])) @ ffn_w2[i]
        h = _layer_norm(ALPHA * h + f, ln2_g[i], ln2_b[i], LN_EPS)
    return h
```

```cpp
#include <hip/hip_runtime.h>
#include <hip/hip_cooperative_groups.h>
#include <cstdio>
#include <cstdint>
namespace pg8 {
#define PG8_LAS __attribute__((address_space(3)))
typedef unsigned short bf16_t;
typedef short bf16x8 __attribute__((ext_vector_type(8)));
typedef float f32x4 __attribute__((ext_vector_type(4)));
typedef unsigned u32x4 __attribute__((ext_vector_type(4)));
constexpr int BM = 256, BK = 64, HALF = 128, HTB = HALF * BK * 2  , STAGE_BYTES = 8 * HTB, NXCD = 8, WGM = 8;

__host__ __device__ __forceinline__ int lds_byte(int r, int c) { const int st = (r >> 4) * 2 + (c >> 5), rr = r & 15, cc = c & 31, ob = rr * 64 + cc * 2; return st * 1024 + (ob ^ (((ob >> 9) & 1) << 5)); }
__host__ __device__ __forceinline__ void stage_rc(int b, int& R, int& C) { const int st = b / 1024, sb = b % 1024, swz = sb ^ (((sb >> 9) & 1) << 5); R = (st >> 1) * 16 + swz / 64; C = (st & 1) * 32 + (swz % 64) / 2; }
__host__ __device__ __forceinline__ int perm32(int rho) { const int n = rho >> 4, i = rho & 15; return 8 * (i >> 2) + 4 * n + (i & 3); }

__device__ __forceinline__ int olane() { unsigned ones = ~0u; asm volatile("" : "+s"(ones)); return (int)__builtin_amdgcn_mbcnt_hi(ones, __builtin_amdgcn_mbcnt_lo(ones, 0u)); }
__device__ __forceinline__ int otid(int wv) { return (wv << 6) | olane(); }
__device__ __forceinline__ int obid() { int b = blockIdx.x; asm volatile("" : "+s"(b)); return b; }
__device__ __forceinline__ int ogrid() { int g = gridDim.x; asm volatile("" : "+s"(g)); return g; }
struct Unit { int pm, pn, pa; };
struct Gemm { const bf16_t* A; const bf16_t* Bt; int M, N, K; };

struct StaticOrder {
    int nM, nN, nwg, G, c; long long amap; int apan;
    __host__ __device__ void init(int M, int N, int G_, int c_) { nM = M / BM; nN = N / BM; nwg = nM * nN; G = G_; c = c_; amap = 0; apan = 0; }
    __host__ __device__ bool next(int i, Unit& u) const {
        const long L = (long)i * G + c; if (L >= nwg) return false;
        int wgid = (int)L; { const int q = nwg / NXCD, r = nwg % NXCD, xcd = wgid % NXCD, off = wgid / NXCD; wgid = (xcd < r ? xcd * (q + 1) : r * (q + 1) + (xcd - r) * q) + off; }
        const int nig = WGM * nN, gid = wgid / nig, fm = gid * WGM, gsz = (nM - fm) < WGM ? (nM - fm) : WGM;
        u.pm = fm + ((wgid % nig) % gsz); u.pn = (wgid % nig) / gsz; u.pa = (int)((amap >> (4 * u.pn)) & 15) * apan + u.pm; return true;
    }
    __device__ __forceinline__ void a_ready(const Unit&) const {}
    __device__ __forceinline__ void done(const Unit&) const {}
};

typedef __bf16 bf16x2_native __attribute__((ext_vector_type(2)));
typedef float f32x2_cvt __attribute__((ext_vector_type(2)));
__device__ __forceinline__ unsigned cvt_pk_bf16(float lo, float hi) { const f32x2_cvt v = {lo, hi}; return __builtin_bit_cast(unsigned, __builtin_convertvector(v, bf16x2_native)); }
typedef float f32x2 __attribute__((ext_vector_type(2)));
__device__ __forceinline__ f32x2 gelu_pk(f32x2 v) {
    const f32x2 av = __builtin_elementwise_abs(v), d = av * 0.2316418882f + 1.0f;
    f32x2 t; t.x = __builtin_amdgcn_rcpf(d.x); t.y = __builtin_amdgcn_rcpf(d.y);
    f32x2 q = t * 0.5307027145f + (-0.7265760135f); q = q * t + 0.7107068705f; q = q * t + (-0.142248368f); q = q * t + 0.127414796f; q = q * t;
    const f32x2 s = (v * v) * (-0.72134752044f);
    f32x2 e; e.x = __builtin_amdgcn_exp2f(s.x); e.y = __builtin_amdgcn_exp2f(s.y);
    const f32x2 m = v * (q * e), r = v - m;
    f32x2 o; o.x = v.x < 0.f ? m.x : r.x; o.y = v.y < 0.f ? m.y : r.y; return o;
}

template <class Epi, class Sched, bool ALIGN_EPI = false, bool SP2 = false>
__device__ __forceinline__ void gemm_phase(PG8_LAS unsigned char* lds, const Gemm g, const Sched& S, const Epi& E, const int wv) {
    const int tid = otid(wv), wid = __builtin_amdgcn_readfirstlane(tid >> 6), lane = tid & 63, wr = wid >> 2, wc = wid & 3, fr = lane & 15, fq = lane >> 4;
    const int K = g.K, nt = K / BK;
    unsigned voffA[2], voffB[2];
#pragma unroll
    for (int i = 0; i < 2; ++i) { int R, C; stage_rc(tid * 16 + i * 8192, R, C); const int Rb = Epi::PERM ? ((R & ~31) + perm32(R & 31)) : R;
        voffA[i] = (unsigned)(R * K + C) * 2u; voffB[i] = (unsigned)(Rb * K + C) * 2u; }
    const size_t kstep = (size_t)(BK * 2);
    const size_t hstep = (size_t)HALF * K * 2;
    const size_t tstep = 2 * hstep;
    const unsigned ldsw = (unsigned)wid * 1024u;
    const int aoff = lds_byte(wr * 64 + fr, fq * 8), boff = lds_byte(wc * 32 + fr, fq * 8);
#define PG8_SA(b, h) (((b) * 2 + (h)) * HTB)
#define PG8_SB(b, h) ((4 + (b) * 2 + (h)) * HTB)
#define PG8_STAGE(bufoff, gbase, voff) do { _Pragma("unroll") for (int _i = 0; _i < 2; ++_i) \
        __builtin_amdgcn_global_load_lds((const unsigned*)((const char*)(gbase) + (voff)[_i]), (PG8_LAS unsigned*)(lds + (bufoff) + ldsw + _i * 8192), 16, 0, 0); } while (0)
#define PG8_LDA(dst, b, h) do { _Pragma("unroll") for (int m = 0; m < 4; ++m) _Pragma("unroll") for (int k = 0; k < 2; ++k) dst[m][k] = *(const PG8_LAS bf16x8*)(lds + PG8_SA(b, h) + aoff + m * 2048 + k * 1024); } while (0)
#define PG8_LDB(dst, b, h) do { _Pragma("unroll") for (int n = 0; n < 2; ++n) _Pragma("unroll") for (int k = 0; k < 2; ++k) dst[n][k] = *(const PG8_LAS bf16x8*)(lds + PG8_SB(b, h) + boff + n * 2048 + k * 1024); } while (0)
#define PG8_MMA(ai, bj, At, Bt) do { __builtin_amdgcn_s_setprio(1); _Pragma("unroll") for (int m = 0; m < 4; ++m) _Pragma("unroll") for (int n = 0; n < 2; ++n) _Pragma("unroll") for (int k = 0; k < 2; ++k) \
        acc[ai][bj][m][n] = __builtin_amdgcn_mfma_f32_16x16x32_bf16(Bt[n][k], At[m][k], acc[ai][bj][m][n], 0, 0, 0); __builtin_amdgcn_s_setprio(0); } while (0)
#define PG8_WAIT_V(n) asm volatile("s_waitcnt vmcnt(" #n ")" ::: "memory")
#define PG8_WAIT_L(n) asm volatile("s_waitcnt lgkmcnt(" #n ")" ::: "memory")
#define PG8_BAR __builtin_amdgcn_s_barrier()
#define PG8_SCHED __builtin_amdgcn_sched_barrier(0)
    Unit cur, nxt; int ui = 0;
    if (!S.next(0, cur)) return;
    f32x4 acc[2][2][4][2];
#pragma unroll
    for (int a = 0; a < 2; ++a)
#pragma unroll
        for (int b = 0; b < 2; ++b)
#pragma unroll
            for (int m = 0; m < 4; ++m)
#pragma unroll
                for (int n = 0; n < 2; ++n) acc[a][b][m][n] = (f32x4){0.f, 0.f, 0.f, 0.f};
    bf16x8 At[4][2], B0[2][2], B1[2][2];
    const char* cA = (const char*)g.A + (size_t)cur.pa * tstep; const char* cB = (const char*)g.Bt + (size_t)cur.pn * tstep;
    S.a_ready(cur);
    if constexpr (SP2) {
        PG8_STAGE(PG8_SB(0, 0), cB, voffB); PG8_STAGE(PG8_SB(0, 1), cB + hstep, voffB); PG8_STAGE(PG8_SA(0, 0), cA, voffA); PG8_STAGE(PG8_SA(0, 1), cA + hstep, voffA);
        if (wr == 1) PG8_BAR;
        PG8_WAIT_V(2); PG8_BAR;
        PG8_STAGE(PG8_SB(1, 0), cB + kstep, voffB); PG8_STAGE(PG8_SA(1, 0), cA + kstep, voffA); PG8_STAGE(PG8_SB(1, 1), cB + hstep + kstep, voffB);
        PG8_WAIT_V(6); PG8_BAR;
    } else {
        PG8_STAGE(PG8_SB(0, 0), cB, voffB); PG8_STAGE(PG8_SA(0, 0), cA, voffA); PG8_STAGE(PG8_SB(0, 1), cB + hstep, voffB); PG8_STAGE(PG8_SA(0, 1), cA + hstep, voffA);
        if (wr == 1) PG8_BAR;
        PG8_WAIT_V(4); PG8_BAR;
        PG8_STAGE(PG8_SB(1, 0), cB + kstep, voffB); PG8_STAGE(PG8_SA(1, 0), cA + kstep, voffA); PG8_STAGE(PG8_SB(1, 1), cB + hstep + kstep, voffB);
        PG8_WAIT_V(6); PG8_BAR;
    }
    for (;;) {
        const bool has_next = S.next(ui + 1, nxt);
        const char* nA = has_next ? (const char*)g.A + (size_t)nxt.pa * tstep : cA; const char* nB = has_next ? (const char*)g.Bt + (size_t)nxt.pn * tstep : cB;
        for (int t = 0; t < nt; t += 2) {
            const bool last = (t == nt - 2);
            const char* a1 = cA + (size_t)(t + 1) * kstep;
            const char* a2 = last ? nA : cA + (size_t)(t + 2) * kstep; const char* b2 = last ? nB : cB + (size_t)(t + 2) * kstep;
            const char* a3 = a2 + kstep; const char* b3 = b2 + kstep;
            if (last && has_next) S.a_ready(nxt);
            if constexpr (SP2) {
            PG8_LDB(B0, 0, 0); PG8_LDB(B1, 0, 1); PG8_SCHED; PG8_LDA(At, 0, 0); PG8_STAGE(PG8_SA(1, 1), a1 + hstep, voffA);
            PG8_WAIT_V(8); PG8_WAIT_L(0); PG8_BAR; PG8_MMA(0, 0, At, B0); PG8_MMA(0, 1, At, B1); PG8_BAR; PG8_SCHED;
            PG8_LDA(At, 0, 1); PG8_STAGE(PG8_SB(0, 0), b2, voffB); PG8_STAGE(PG8_SB(0, 1), b2 + hstep, voffB); PG8_STAGE(PG8_SA(0, 0), a2, voffA);
            PG8_WAIT_V(8); PG8_WAIT_L(0); PG8_BAR; PG8_MMA(1, 0, At, B0); PG8_MMA(1, 1, At, B1); PG8_BAR; PG8_SCHED;
            PG8_LDB(B0, 1, 0); PG8_LDB(B1, 1, 1); PG8_SCHED; PG8_LDA(At, 1, 0); PG8_STAGE(PG8_SA(0, 1), a2 + hstep, voffA);
            PG8_WAIT_V(8); PG8_WAIT_L(0); PG8_BAR; PG8_MMA(0, 0, At, B0); PG8_MMA(0, 1, At, B1); PG8_BAR; PG8_SCHED;
            PG8_LDA(At, 1, 1); PG8_STAGE(PG8_SB(1, 0), b3, voffB); PG8_STAGE(PG8_SB(1, 1), b3 + hstep, voffB); PG8_STAGE(PG8_SA(1, 0), a3, voffA);
            PG8_WAIT_V(8); PG8_WAIT_L(0); PG8_BAR; PG8_MMA(1, 0, At, B0); PG8_MMA(1, 1, At, B1); PG8_BAR; PG8_SCHED;
            } else {
            PG8_LDB(B0, 0, 0); PG8_SCHED; PG8_LDA(At, 0, 0); PG8_STAGE(PG8_SA(1, 1), a1 + hstep, voffA);
            PG8_WAIT_L(8); PG8_BAR; PG8_WAIT_L(0); PG8_MMA(0, 0, At, B0); PG8_BAR; PG8_SCHED;
            PG8_LDB(B1, 0, 1); PG8_STAGE(PG8_SB(0, 0), b2, voffB);
            PG8_BAR; PG8_WAIT_L(0); PG8_MMA(0, 1, At, B1); PG8_BAR;
            PG8_LDA(At, 0, 1); PG8_STAGE(PG8_SA(0, 0), a2, voffA);
            PG8_BAR; PG8_WAIT_L(0); PG8_MMA(1, 0, At, B0); PG8_BAR; PG8_SCHED;
            PG8_STAGE(PG8_SB(0, 1), b2 + hstep, voffB);
            PG8_WAIT_V(6); PG8_BAR; PG8_MMA(1, 1, At, B1); PG8_BAR;
            PG8_LDB(B0, 1, 0); PG8_SCHED; PG8_LDA(At, 1, 0); PG8_STAGE(PG8_SA(0, 1), a2 + hstep, voffA);
            PG8_WAIT_L(8); PG8_BAR; PG8_WAIT_L(0); PG8_MMA(0, 0, At, B0); PG8_BAR; PG8_SCHED;
            PG8_LDB(B1, 1, 1); PG8_STAGE(PG8_SB(1, 0), b3, voffB);
            PG8_BAR; PG8_WAIT_L(0); PG8_MMA(0, 1, At, B1); PG8_BAR;
            PG8_LDA(At, 1, 1); PG8_STAGE(PG8_SA(1, 0), a3, voffA);
            PG8_BAR; PG8_WAIT_L(0); PG8_MMA(1, 0, At, B0); PG8_BAR; PG8_SCHED;
            PG8_STAGE(PG8_SB(1, 1), b3 + hstep, voffB);
            PG8_WAIT_V(6); PG8_BAR; PG8_MMA(1, 1, At, B1); PG8_BAR;
            }
        }
        if constexpr (ALIGN_EPI) { if (wr == 0) PG8_BAR; }
        if constexpr (!Epi::AFTER_DRAIN) { E(acc, cur, wr, wc, fr, fq); S.done(cur); }
        if (!has_next) break;
#pragma unroll
        for (int a = 0; a < 2; ++a)
#pragma unroll
            for (int b = 0; b < 2; ++b)
#pragma unroll
                for (int m = 0; m < 4; ++m)
#pragma unroll
                    for (int n = 0; n < 2; ++n) acc[a][b][m][n] = (f32x4){0.f, 0.f, 0.f, 0.f};
        cur = nxt; cA = nA; cB = nB; ++ui;
        if constexpr (ALIGN_EPI) { if (wr == 1) PG8_BAR; }
    }
    PG8_WAIT_V(0);
    if constexpr (!ALIGN_EPI) { if (wr == 0) PG8_BAR; }
    PG8_BAR;
    if constexpr (Epi::AFTER_DRAIN) { E.fused(acc, cur, wr, wc, fr, fq, lds, wid, lane); S.done(cur); }
#undef PG8_SA
#undef PG8_SB
#undef PG8_STAGE
#undef PG8_LDA
#undef PG8_LDB
#undef PG8_MMA
#undef PG8_WAIT_V
#undef PG8_WAIT_L
#undef PG8_BAR
#undef PG8_SCHED
}
}

namespace cg = cooperative_groups;
#define LAS __attribute__((address_space(3)))
typedef unsigned short bf16;
typedef float f32x4 __attribute__((ext_vector_type(4)));
typedef float f32x2 __attribute__((ext_vector_type(2)));
typedef unsigned u32x4 __attribute__((ext_vector_type(4)));
typedef unsigned u32x2 __attribute__((ext_vector_type(2)));
typedef short bf16x8 __attribute__((ext_vector_type(8)));

constexpr int NB = 8, SEQ = 4096, T = NB * SEQ, D = 1024, FF = 4096;
constexpr float ALPHA = 1.681792830507429f;
constexpr float LN_EPS = 1e-5f, GN_EPS = 64e-5f;
constexpr int LDS_BYTES = 155648;
constexpr size_t MiB = 1u << 20;
constexpr size_t WS_W = 4 * MiB, WS_HB = 32 * MiB, WS_VF = 96 * MiB, WS_P = 160 * MiB;
constexpr size_t W_WIN = 0, W_WOUT = 4 * MiB, W_WSC = 6 * MiB;
constexpr size_t W_STK = 0, W_WO = 8 * MiB, W_LW2 = 10 * MiB, W_LA2 = 10 * MiB + 256 * 1024, W_LV2 = 10 * MiB + 512 * 1024, W_LG2 = 10 * MiB + 768 * 1024;
constexpr size_t W_W1 = 12 * MiB, W_W2 = 20 * MiB;
constexpr size_t P_S0 = WS_P, P_S1 = WS_P + 64 * MiB, P_S2 = WS_P + 128 * MiB, P_S3 = WS_P + 192 * MiB;
constexpr size_t P_LW = WS_P + 256 * MiB, P_LA = WS_P + 264 * MiB, P_LV = WS_P + 272 * MiB, P_LG = WS_P + 280 * MiB;

struct Args { const float* in[32]; float* out; unsigned char* ws; };
__device__ __forceinline__ const float* argp(int i) {
    const __attribute__((address_space(4))) unsigned char* k = (const __attribute__((address_space(4))) unsigned char*)__builtin_amdgcn_kernarg_segment_ptr();
    int off = i * 8; asm volatile("" : "+s"(off));
    return *(const float* const __attribute__((address_space(4)))*)(k + off);
}

__device__ __forceinline__ unsigned pk2(float lo, float hi) { return pg8::cvt_pk_bf16(lo, hi); }
__device__ __forceinline__ float bflo(unsigned w) { return __uint_as_float(w << 16); }
__device__ __forceinline__ float bfhi(unsigned w) { return __uint_as_float(w & 0xffff0000u); }
__device__ __forceinline__ f32x4 unpk4(u32x2 w) { return (f32x4){bflo(w.x), bfhi(w.x), bflo(w.y), bfhi(w.y)}; }
__device__ __forceinline__ u32x2 pk4(f32x4 v) { u32x2 w; w.x = pk2(v.x, v.y); w.y = pk2(v.z, v.w); return w; }
__device__ __forceinline__ void st8(bf16* p, f32x4 a, f32x4 b) { u32x4 w; w.x = pk2(a.x, a.y); w.y = pk2(a.z, a.w); w.z = pk2(b.x, b.y); w.w = pk2(b.z, b.w); *(u32x4*)p = w; }
__device__ __forceinline__ void ld8(const bf16* p, f32x4& a, f32x4& b) { const u32x4 w = *(const u32x4*)p; a = (f32x4){bflo(w.x), bfhi(w.x), bflo(w.y), bfhi(w.y)}; b = (f32x4){bflo(w.z), bfhi(w.z), bflo(w.w), bfhi(w.w)}; }
__device__ __forceinline__ float sigm(float x) { return __builtin_amdgcn_rcpf(1.0f + __expf(-x)); }
__device__ __forceinline__ f32x4 sigm4(f32x4 v) { return (f32x4){sigm(v.x), sigm(v.y), sigm(v.z), sigm(v.w)}; }
__device__ __forceinline__ float tanh_f(float x) { return 1.0f - 2.0f * __builtin_amdgcn_rcpf(1.0f + __expf(2.0f * x)); }
__device__ __forceinline__ f32x4 tanh4(f32x4 v) { return (f32x4){tanh_f(v.x), tanh_f(v.y), tanh_f(v.z), tanh_f(v.w)}; }
__device__ __forceinline__ f32x4 gelu4(f32x4 v) { const f32x2 a = pg8::gelu_pk((f32x2){v.x, v.y}), b = pg8::gelu_pk((f32x2){v.z, v.w}); return (f32x4){a.x, a.y, b.x, b.y}; }
template <int CTRL> __device__ __forceinline__ float dppf(float x) { return __builtin_bit_cast(float, __builtin_amdgcn_update_dpp(0, __builtin_bit_cast(int, x), CTRL, 0xF, 0xF, true)); }
__device__ __forceinline__ float red16(float x) { x += dppf<0xB1>(x); x += dppf<0x4E>(x); x += dppf<0x141>(x); x += dppf<0x140>(x); return x; }
__device__ __forceinline__ float wave_sum(float v) { const float r = red16(v); const int ri = __builtin_bit_cast(int, r);
    return (__builtin_bit_cast(float, __builtin_amdgcn_readlane(ri, 0)) + __builtin_bit_cast(float, __builtin_amdgcn_readlane(ri, 16))) + (__builtin_bit_cast(float, __builtin_amdgcn_readlane(ri, 32)) + __builtin_bit_cast(float, __builtin_amdgcn_readlane(ri, 48))); }
__device__ __forceinline__ float sum4(f32x4 v) { return (v.x + v.y) + (v.z + v.w); }

#define WSB(off) ((unsigned char*)argp(33) + (off))
#define WSBF(off) ((bf16*)WSB(off))
#define HPTR ((float*)argp(32))
#define RBUF ((bf16*)argp(32))
template <class Op> struct Epi8 {
    static constexpr bool PERM = true, AFTER_DRAIN = false;
    Op op; int row_off;
    __device__ __forceinline__ void operator()(const f32x4 (&acc)[2][2][4][2], const pg8::Unit& u, int wr, int wc, int, int) const {
        const int lane_ = pg8::olane();
        const int fr = lane_ & 15, fq = lane_ >> 4;
        const int row0 = row_off + u.pm * 256 + wr * 64 + fr, colb = wc * 32 + 8 * fq;
        if constexpr (Op::PRE) {
#pragma unroll
            for (int ai = 0; ai < 2; ++ai) {
                u32x4 pre[4][2];
#pragma unroll
                for (int m = 0; m < 4; ++m)
#pragma unroll
                    for (int bj = 0; bj < 2; ++bj) pre[m][bj] = op.pre(row0 + ai * 128 + m * 16, u.pn, bj * 128 + colb);
#pragma unroll
                for (int m = 0; m < 4; ++m)
#pragma unroll
                    for (int bj = 0; bj < 2; ++bj) op.post(row0 + ai * 128 + m * 16, u.pn, bj * 128 + colb, acc[ai][bj][m][0], acc[ai][bj][m][1], pre[m][bj]);
                asm volatile("" ::: "memory");
            }
        } else {
#pragma unroll
            for (int ai = 0; ai < 2; ++ai)
#pragma unroll
                for (int m = 0; m < 4; ++m)
                {
#pragma unroll
                    for (int bj = 0; bj < 2; ++bj) op(row0 + ai * 128 + m * 16, u.pn, bj * 128 + colb, acc[ai][bj][m][0], acc[ai][bj][m][1]);
                    asm volatile("" ::: "memory");
                }
        }
    }
};
__device__ __forceinline__ void unpk8(u32x4 w, f32x4& a, f32x4& b) { a = (f32x4){bflo(w.x), bfhi(w.x), bflo(w.y), bfhi(w.y)}; b = (f32x4){bflo(w.z), bfhi(w.z), bflo(w.w), bfhi(w.w)}; }
struct OpGelu { static constexpr bool PRE = false; bf16* O;
    __device__ __forceinline__ void operator()(int row, int pn, int ct, f32x4 v0, f32x4 v1) const { st8(O + (size_t)row * 2048 + pn * 256 + ct, gelu4(v0), gelu4(v1)); } };
struct OpRelu2 { static constexpr bool PRE = false; bf16* O;
    __device__ __forceinline__ void operator()(int row, int pn, int ct, f32x4 v0, f32x4 v1) const {
        v0 = __builtin_elementwise_max(v0, (f32x4){0.f, 0.f, 0.f, 0.f}); v1 = __builtin_elementwise_max(v1, (f32x4){0.f, 0.f, 0.f, 0.f});
        st8(O + (size_t)row * FF + pn * 256 + ct, v0 * v0, v1 * v1); } };
struct OpResid { static constexpr bool PRE = false; float* H;
    __device__ __forceinline__ void operator()(int row, int pn, int ct, f32x4 v0, f32x4 v1) const {
        float* p = H + (size_t)row * D + pn * 256 + ct; const f32x4 a = *(const f32x4*)p, b = *(const f32x4*)(p + 4);
        *(f32x4*)p = a * ALPHA + v0; *(f32x4*)(p + 4) = b * ALPHA + v1; } };
struct OpResidB { static constexpr bool PRE = true; bf16* HB;
    __device__ __forceinline__ u32x4 pre(int row, int pn, int ct) const { return *(const u32x4*)(HB + (size_t)row * D + pn * 256 + ct); }
    __device__ __forceinline__ void post(int row, int pn, int ct, f32x4 v0, f32x4 v1, u32x4 p) const { f32x4 a, b; unpk8(p, a, b); st8(HB + (size_t)row * D + pn * 256 + ct, a * ALPHA + v0, b * ALPHA + v1); } };
struct OpResidF { static constexpr bool PRE = true; float* Y; const bf16* HB;
    __device__ __forceinline__ u32x4 pre(int row, int pn, int ct) const { return *(const u32x4*)(HB + (size_t)row * D + pn * 256 + ct); }
    __device__ __forceinline__ void post(int row, int pn, int ct, f32x4 v0, f32x4 v1, u32x4 p) const { const size_t off = (size_t)row * D + pn * 256 + ct; f32x4 a, b; unpk8(p, a, b);
        *(f32x4*)(Y + off) = a * ALPHA + v0; *(f32x4*)(Y + off + 4) = b * ALPHA + v1; } };
struct OpR1 { static constexpr bool PRE = false; bf16 *R, *K, *V, *LW, *LA, *LG, *LV;
    __device__ __forceinline__ void operator()(int row, int pn, int ct, f32x4 v0, f32x4 v1) const {
        const f32x4 z = (f32x4){0.f, 0.f, 0.f, 0.f};
        if (pn < 12) { const long long dK = (const char*)K - (const char*)R, dV = (const char*)V - (const char*)R;
            bf16* base = (bf16*)((char*)R + ((pn >= 4 && pn < 8) ? dK : 0ll) + (pn >= 8 ? dV : 0ll)); st8(base + (size_t)row * D + (pn & 3) * 256 + ct, v0, v1); }
        else if (pn == 12) { if (ct < 128) { if (ct < 64) { v0 = tanh4(v0); v1 = tanh4(v1); } else { v0 = z; v1 = z; } st8(LW + (size_t)row * 128 + ct, v0, v1); } }
        else if (pn == 13) { if (ct < 128) { if (ct >= 64) { v0 = z; v1 = z; } st8(LA + (size_t)row * 128 + ct, v0, v1); } }
        else if (pn == 14) { if (ct < 160) { v0 = sigm4(v0); v1 = sigm4(v1); } else { v0 = z; v1 = z; } st8(LG + (size_t)row * 256 + ct, v0, v1); }
        else { if (ct < 128) { if (ct >= 32) { v0 = z; v1 = z; } st8(LV + (size_t)row * 128 + ct, v0, v1); } }
    } };
struct OpVupd { static constexpr bool PRE = false; bf16* V; const bf16* VF; const float* v0p;
    __device__ __forceinline__ void operator()(int row, int pn, int ct, f32x4 v0, f32x4 v1) const {
        const int col = pn * 256 + ct; const size_t off = (size_t)row * D + col;
        const f32x4 g0 = sigm4(v0 + *(const f32x4*)(v0p + col)), g1 = sigm4(v1 + *(const f32x4*)(v0p + col + 4));
        f32x4 a, b, fa, fb; ld8(V + off, a, b); ld8(VF + off, fa, fb);
        st8(V + off, a + (fa - a) * g0, b + (fb - b) * g1); } };
struct OpE { static constexpr bool PRE = false; bf16* E; const float* w0;
    __device__ __forceinline__ void operator()(int row, int pn, int ct, f32x4 v0, f32x4 v1) const {
        const int col = pn * 256 + ct;
        st8(E + (size_t)row * D + col, sigm4(v0 + *(const f32x4*)(w0 + col)) * 0.6065306597f, sigm4(v1 + *(const f32x4*)(w0 + col + 4)) * 0.6065306597f); } };
struct OpA { static constexpr bool PRE = false; bf16* A; const float* a0;
    __device__ __forceinline__ void operator()(int row, int pn, int ct, f32x4 v0, f32x4 v1) const {
        const int col = pn * 256 + ct;
        st8(A + (size_t)row * D + col, sigm4(v0 + *(const f32x4*)(a0 + col)), sigm4(v1 + *(const f32x4*)(a0 + col + 4))); } };
struct OpG { static constexpr bool PRE = true; bf16* O; const bf16* PREB;
    __device__ __forceinline__ u32x4 pre(int row, int pn, int ct) const { return *(const u32x4*)(PREB + (size_t)row * D + pn * 256 + ct); }
    __device__ __forceinline__ void post(int row, int pn, int ct, f32x4 v0, f32x4 v1, u32x4 p) const { f32x4 a, b; unpk8(p, a, b); st8(O + (size_t)row * D + pn * 256 + ct, a * v0, b * v1); } };

template <class Op, bool ALIGN>
__device__ __forceinline__ void run_gemm(const int wv, LAS unsigned char* lds, const bf16* A, const bf16* Bt, int M, int N, int K, const Op& op, int row_off = 0, long long amap = 0, int apan = 0) {
    pg8::Gemm g{A, Bt, M, N, K}; pg8::StaticOrder S; S.init(M, N, (int)pg8::ogrid(), (int)pg8::obid()); S.amap = amap; S.apan = apan;
    Epi8<Op> E{op, row_off};
    pg8::gemm_phase<Epi8<Op>, pg8::StaticOrder, ALIGN, true>(lds, g, S, E, wv);
}

__device__ __forceinline__ void tr_item(const float* W, int K, int N, bf16* WT, int ldk, int row_off, LAS float* scr, int item, int lane) {
    const int nblk = N / 32, kb = item / nblk, nb = item % nblk, k0 = 64 * kb, n0 = 32 * nb;
#pragma unroll
    for (int i = 0; i < 32; ++i) { const int kk = 2 * i + (lane >> 5), kg = k0 + kk; scr[kk * 33 + (lane & 31)] = kg < K ? W[(size_t)kg * N + n0 + (lane & 31)] : 0.f; }
    asm volatile("s_waitcnt lgkmcnt(0)" ::: "memory");
    const int c = lane & 7;
#pragma unroll
    for (int j = 0; j < 4; ++j) { const int n = (lane >> 3) + 8 * j; const LAS float* s = scr + (8 * c) * 33 + n;
        u32x4 o; o.x = pk2(s[0 * 33], s[1 * 33]); o.y = pk2(s[2 * 33], s[3 * 33]); o.z = pk2(s[4 * 33], s[5 * 33]); o.w = pk2(s[6 * 33], s[7 * 33]);
        *(u32x4*)(WT + (size_t)(row_off + n0 + n) * ldk + k0 + 8 * c) = o; }
    asm volatile("s_waitcnt lgkmcnt(0)" ::: "memory");
}
#define CV_ITEM(Wp_, K_, N_, Kpad_, WTp_, roff_) { const int ni_ = ((Kpad_) / 64) * ((N_) / 32); if (r < ni_) { tr_item((Wp_), (K_), (N_), (WTp_), (Kpad_), (roff_), scr, r, lane); continue; } r -= ni_; }
__device__ __forceinline__ void conv_layer(const int wv, int layer, LAS unsigned char* lds) {
    const int tid = pg8::otid(wv), lane = tid & 63, wave = tid >> 6;
    const int gw = pg8::obid() * 8 + wave, ngw = pg8::ogrid() * 8;
    LAS float* scr = (LAS float*)(lds + wave * 16384);
    const int j = layer >> 1;
    const bool gm = (layer & 1) == 0;
    if (gm) {
        const float* ws = argp(10) + (size_t)j * 8 * 128 * 128; bf16* wsc = (bf16*)(WSB(WS_W) + W_WSC);
        for (int i = pg8::obid() * 512 + tid; i < 8 * 128 * 128 / 2; i += pg8::ogrid() * 512) {
            const int e = 2 * i, t = (e >> 7) & 127, s = e & 127; const f32x2 v = *(const f32x2*)(ws + e);
            *(unsigned*)(wsc + e) = pk2(s <= t ? v.x : 0.f, (s + 1) <= t ? v.y : 0.f); }
    }
    const int total = 2 * 2048 + (gm ? 1024 + 512 : 3 * 512 + 32 + 32 + 80 + 512 + 64 + 64 + 128 + (j > 0 ? 16 + 64 : 0));
    for (int it = gw; it < total; it += ngw) {
        int r = it;
        CV_ITEM(argp(5) + (size_t)layer * D * FF, D, FF, D, (bf16*)(WSB(WS_W) + W_W1), 0)
        CV_ITEM(argp(6) + (size_t)layer * FF * D, FF, D, FF, (bf16*)(WSB(WS_W) + W_W2), 0)
        if (gm) {
            CV_ITEM(argp(7) + (size_t)j * D * 2048, D, 2048, D, (bf16*)(WSB(WS_W) + W_WIN), 0)
            CV_ITEM(argp(12) + (size_t)j * D * D, D, D, D, (bf16*)(WSB(WS_W) + W_WOUT), 0)
        } else {
            CV_ITEM(argp(14) + (size_t)j * 3 * D * D, D, D, D, (bf16*)(WSB(WS_W) + W_STK), 0)
            CV_ITEM(argp(14) + (size_t)j * 3 * D * D + (size_t)D * D, D, D, D, (bf16*)(WSB(WS_W) + W_STK), 1024)
            CV_ITEM(argp(14) + (size_t)j * 3 * D * D + (size_t)2 * D * D, D, D, D, (bf16*)(WSB(WS_W) + W_STK), 2048)
            CV_ITEM(argp(16) + (size_t)j * D * 64, D, 64, D, (bf16*)(WSB(WS_W) + W_STK), 3072)
            CV_ITEM(argp(19) + (size_t)j * D * 64, D, 64, D, (bf16*)(WSB(WS_W) + W_STK), 3328)
            CV_ITEM(argp(21) + (size_t)j * D * 160, D, 160, D, (bf16*)(WSB(WS_W) + W_STK), 3584)
            CV_ITEM(argp(28) + (size_t)j * D * D, D, D, D, (bf16*)(WSB(WS_W) + W_WO), 0)
            CV_ITEM(argp(17) + (size_t)j * 64 * D, 64, D, 128, (bf16*)(WSB(WS_W) + W_LW2), 0)
            CV_ITEM(argp(20) + (size_t)j * 64 * D, 64, D, 128, (bf16*)(WSB(WS_W) + W_LA2), 0)
            CV_ITEM(argp(22) + (size_t)j * 160 * D, 160, D, 256, (bf16*)(WSB(WS_W) + W_LG2), 0)
            if (j > 0) {
                CV_ITEM(argp(30) + (size_t)(j - 1) * D * 32, D, 32, D, (bf16*)(WSB(WS_W) + W_STK), 3840)
                CV_ITEM(argp(31) + (size_t)(j - 1) * 32 * D, 32, D, 128, (bf16*)(WSB(WS_W) + W_LV2), 0)
            }
        }
    }
}
#undef CV_ITEM

__device__ __forceinline__ void ph_init_rows(const int wv, const float* x, float* H, bf16* HB) {
    const int tid = pg8::otid(wv), lane = tid & 63, gw = pg8::obid() * 8 + (tid >> 6), ngw = pg8::ogrid() * 8;
    for (int m0 = gw * 4; m0 < T; m0 += ngw * 4) {
        f32x4 v[4][4];
#pragma unroll
        for (int r = 0; r < 4; ++r)
#pragma unroll
            for (int jj = 0; jj < 4; ++jj) v[r][jj] = *(const f32x4*)(x + (size_t)(m0 + r) * D + 4 * lane + 256 * jj);
#pragma unroll
        for (int r = 0; r < 4; ++r)
#pragma unroll
            for (int jj = 0; jj < 4; ++jj) *(u32x2*)(HB + (size_t)(m0 + r) * D + 4 * lane + 256 * jj) = pk4(v[r][jj]);
    }
}
__device__ __forceinline__ void ph_ln(const int wv, float* H, bf16* HB, const float* g, const float* b, const bool src_h, const bool want_h, const bool want_hb) {
    const int tid = pg8::otid(wv), lane = tid & 63, gw = pg8::obid() * 8 + (tid >> 6), ngw = pg8::ogrid() * 8;
    f32x4 gv[4], bv[4];
#pragma unroll
    for (int jj = 0; jj < 4; ++jj) { gv[jj] = *(const f32x4*)(g + 4 * lane + 256 * jj); bv[jj] = *(const f32x4*)(b + 4 * lane + 256 * jj); }
    for (int m0 = gw; m0 < T; m0 += 2 * ngw) {
        const int m1 = m0 + ngw;
        float* hr0 = H + (size_t)m0 * D + 4 * lane; bf16* br0 = HB + (size_t)m0 * D + 4 * lane;
        float* hr1 = H + (size_t)(m1 < T ? m1 : m0) * D + 4 * lane; bf16* br1 = HB + (size_t)(m1 < T ? m1 : m0) * D + 4 * lane;
        f32x4 v[4], w[4];
        if (src_h) {
#pragma unroll
            for (int jj = 0; jj < 4; ++jj) { v[jj] = *(const f32x4*)(hr0 + 256 * jj); w[jj] = *(const f32x4*)(hr1 + 256 * jj); }
        } else {
#pragma unroll
            for (int jj = 0; jj < 4; ++jj) { v[jj] = unpk4(*(const u32x2*)(br0 + 256 * jj)); w[jj] = unpk4(*(const u32x2*)(br1 + 256 * jj)); }
        }
        float s0 = 0.f, s1 = 0.f;
#pragma unroll
        for (int jj = 0; jj < 4; ++jj) { s0 += sum4(v[jj]); s1 += sum4(w[jj]); }
        const float mean0 = wave_sum(s0) * (1.0f / D), mean1 = wave_sum(s1) * (1.0f / D); float q0 = 0.f, q1 = 0.f;
#pragma unroll
        for (int jj = 0; jj < 4; ++jj) { v[jj] = v[jj] - mean0; q0 += sum4(v[jj] * v[jj]); w[jj] = w[jj] - mean1; q1 += sum4(w[jj] * w[jj]); }
        const float rstd0 = 1.0f / sqrtf(wave_sum(q0) * (1.0f / D) + LN_EPS), rstd1 = 1.0f / sqrtf(wave_sum(q1) * (1.0f / D) + LN_EPS);
#pragma unroll
        for (int jj = 0; jj < 4; ++jj) { const f32x4 o = v[jj] * rstd0 * gv[jj] + bv[jj]; if (want_h) *(f32x4*)(hr0 + 256 * jj) = o; if (want_hb) *(u32x2*)(br0 + 256 * jj) = pk4(o); }
        if (m1 < T) {
#pragma unroll
            for (int jj = 0; jj < 4; ++jj) { const f32x4 o = w[jj] * rstd1 * gv[jj] + bv[jj]; if (want_h) *(f32x4*)(hr1 + 256 * jj) = o; if (want_hb) *(u32x2*)(br1 + 256 * jj) = pk4(o); }
        }
    }
}
__device__ __forceinline__ void ph_mixprep(const int wv, const bf16* HB, bf16* XMIX, const float* mu, int q) {
    constexpr int PR = T / 4;
    const int tid = pg8::otid(wv), lane = tid & 63, gw = pg8::obid() * 8 + (tid >> 6), ngw = pg8::ogrid() * 8;
    for (int lm0 = gw * 4; lm0 < PR; lm0 += ngw * 4) {
        const int m0 = q * PR + lm0; const bool first = (m0 % SEQ) == 0;
        u32x2 raw[5][4];
#pragma unroll
        for (int r = 0; r < 5; ++r)
#pragma unroll
            for (int jj = 0; jj < 4; ++jj) raw[r][jj] = (r == 0 && first) ? (u32x2){0u, 0u} : *(const u32x2*)(HB + (size_t)(m0 + r - 1) * D + 4 * lane + 256 * jj);
#pragma unroll
        for (int jj = 0; jj < 4; ++jj) { const int col = 4 * lane + 256 * jj;
            f32x4 mv[6];
#pragma unroll
            for (int i = 0; i < 6; ++i) mv[i] = *(const f32x4*)(mu + i * D + col);
#pragma unroll
            for (int r = 0; r < 4; ++r) { const f32x4 xp = unpk4(raw[r][jj]), x = unpk4(raw[r + 1][jj]); const f32x4 xx = xp - x;
#pragma unroll
                for (int i = 0; i < 6; ++i) *(u32x2*)(XMIX + ((size_t)i * PR + lm0 + r) * D + col) = pk4(x + xx * mv[i]); }
        }
    }
}
__device__ __forceinline__ void ph_post(const int wv, bf16* Y, const bf16* R, const bf16* K, const bf16* V, const bf16* A, const float* k_a, const float* r_k, const float* gn_g, const float* gn_b) {
    const int tid = pg8::otid(wv), lane = tid & 63, gw = pg8::obid() * 8 + (tid >> 6), ngw = pg8::ogrid() * 8;
    for (int m0 = gw * 2; m0 < T; m0 += ngw * 2) {
        u32x2 ry[2][4], rr[2][4], rk[2][4], rv[2][4], ra[2][4];
#pragma unroll
        for (int r = 0; r < 2; ++r)
#pragma unroll
            for (int jj = 0; jj < 4; ++jj) { const size_t off = (size_t)(m0 + r) * D + 4 * lane + 256 * jj;
                ry[r][jj] = *(const u32x2*)(Y + off); rr[r][jj] = *(const u32x2*)(R + off); rk[r][jj] = *(const u32x2*)(K + off); rv[r][jj] = *(const u32x2*)(V + off); ra[r][jj] = *(const u32x2*)(A + off); }
#pragma unroll
        for (int jj = 0; jj < 4; ++jj) { const int col = 4 * lane + 256 * jj;
            const f32x4 ka = *(const f32x4*)(k_a + col), rkk = *(const f32x4*)(r_k + col), gg = *(const f32x4*)(gn_g + col), gb = *(const f32x4*)(gn_b + col);
#pragma unroll
            for (int r = 0; r < 2; ++r) { const size_t off = (size_t)(m0 + r) * D + col;
                const f32x4 y = unpk4(ry[r][jj]), rq = unpk4(rr[r][jj]), k = unpk4(rk[r][jj]), v = unpk4(rv[r][jj]), a = unpk4(ra[r][jj]);
                const float mean = red16(sum4(y)) * (1.0f / 64.0f); const f32x4 d = y - mean;
                const float var = red16(sum4(d * d)) * (1.0f / 64.0f); const float rstd = 1.0f / sqrtf(var + GN_EPS);
                const f32x4 kp = k * ((a - 1.0f) * ka + 1.0f);
                const float s = red16(sum4(rq * kp * rkk));
                *(u32x2*)(Y + off) = pk4(d * rstd * gg + gb + v * s); }
        }
    }
}

__device__ __forceinline__ void ph_spatial(const int wv, LAS unsigned char* lds, const bf16* ZB, bf16* GB, const bf16* WSC, const float* vng, const float* vnb, const float* bs) {
    const int tid = pg8::otid(wv), lane = tid & 63, wave = tid >> 6, fr = lane & 15, fq = lane >> 4;
    LAS bf16* Wc = (LAS bf16*)lds; LAS bf16* vT = (LAS bf16*)(lds + 34816); LAS float* stats = (LAS float*)(lds + 69632);
    for (int ch = pg8::obid(); ch < T / 128; ch += pg8::ogrid()) {
        const size_t row0 = (size_t)ch * 128;
#pragma unroll 1
        for (int rb = 0; rb < 16; rb += 8) {
            u32x4 ra[8], rc[8];
#pragma unroll
            for (int rr = 0; rr < 8; ++rr) { const bf16* vp = ZB + (row0 + wave * 16 + rb + rr) * 2048 + 1024 + 8 * lane; ra[rr] = *(const u32x4*)vp; rc[rr] = *(const u32x4*)(vp + 512); }
#pragma unroll
            for (int rr = 0; rr < 8; ++rr) { const int s = wave * 16 + rb + rr;
                f32x4 a = (f32x4){bflo(ra[rr].x), bfhi(ra[rr].x), bflo(ra[rr].y), bfhi(ra[rr].y)}, b = (f32x4){bflo(ra[rr].z), bfhi(ra[rr].z), bflo(ra[rr].w), bfhi(ra[rr].w)};
                f32x4 c = (f32x4){bflo(rc[rr].x), bfhi(rc[rr].x), bflo(rc[rr].y), bfhi(rc[rr].y)}, d = (f32x4){bflo(rc[rr].z), bfhi(rc[rr].z), bflo(rc[rr].w), bfhi(rc[rr].w)};
                const float mean = wave_sum((sum4(a) + sum4(b)) + (sum4(c) + sum4(d))) * (1.0f / 1024.0f);
                a = a - mean; b = b - mean; c = c - mean; d = d - mean;
                const float var = wave_sum((sum4(a * a) + sum4(b * b)) + (sum4(c * c) + sum4(d * d))) * (1.0f / 1024.0f);
                if (lane == 0) { stats[2 * s] = mean; stats[2 * s + 1] = 1.0f / sqrtf(var + LN_EPS); } }
        }
        __syncthreads();
        u32x4 wR[4], vR[2][2]; f32x4 pg0[2], pg1[2], po0[2], po1[2];
#define SP_LOAD(g_) do { _Pragma("unroll") for (int i = 0; i < 4; ++i) { const int p = tid + 512 * i, row = p >> 4, c8 = (p & 15) * 8; wR[i] = *(const u32x4*)(WSC + (g_) * 16384 + row * 128 + c8); } \
            _Pragma("unroll") for (int q = 0; q < 2; ++q) { const int col = (g_) * 128 + (wave * 2 + q) * 8; \
                vR[q][0] = *(const u32x4*)(ZB + (row0 + 2 * lane) * 2048 + 1024 + col); vR[q][1] = *(const u32x4*)(ZB + (row0 + 2 * lane + 1) * 2048 + 1024 + col); \
                pg0[q] = *(const f32x4*)(vng + col); pg1[q] = *(const f32x4*)(vng + col + 4); po0[q] = *(const f32x4*)(vnb + col); po1[q] = *(const f32x4*)(vnb + col + 4); } } while (0)
        SP_LOAD(0);
        const int tb = wave >> 1, db = wave & 1;
        for (int g = 0; g < 8; ++g) {
#pragma unroll
            for (int i = 0; i < 4; ++i) { const int p = tid + 512 * i, row = p >> 4, c8 = (p & 15) * 8; *(LAS u32x4*)(Wc + row * 136 + c8) = wR[i]; }
            { const int s = 2 * lane; const f32x4 sv = *(const LAS f32x4*)(stats + 2 * s);
#pragma unroll
              for (int q = 0; q < 2; ++q) { const int d8 = (wave * 2 + q) * 8;
                  f32x4 a0 = (f32x4){bflo(vR[q][0].x), bfhi(vR[q][0].x), bflo(vR[q][0].y), bfhi(vR[q][0].y)}, a1 = (f32x4){bflo(vR[q][0].z), bfhi(vR[q][0].z), bflo(vR[q][0].w), bfhi(vR[q][0].w)};
                  f32x4 b0 = (f32x4){bflo(vR[q][1].x), bfhi(vR[q][1].x), bflo(vR[q][1].y), bfhi(vR[q][1].y)}, b1 = (f32x4){bflo(vR[q][1].z), bfhi(vR[q][1].z), bflo(vR[q][1].w), bfhi(vR[q][1].w)};
                  a0 = (a0 - sv.x) * sv.y * pg0[q] + po0[q]; a1 = (a1 - sv.x) * sv.y * pg1[q] + po1[q]; b0 = (b0 - sv.z) * sv.w * pg0[q] + po0[q]; b1 = (b1 - sv.z) * sv.w * pg1[q] + po1[q];
                  LAS bf16* dst = vT + d8 * 136 + s;
                  *(LAS unsigned*)(dst + 0 * 136) = pk2(a0.x, b0.x); *(LAS unsigned*)(dst + 1 * 136) = pk2(a0.y, b0.y); *(LAS unsigned*)(dst + 2 * 136) = pk2(a0.z, b0.z); *(LAS unsigned*)(dst + 3 * 136) = pk2(a0.w, b0.w);
                  *(LAS unsigned*)(dst + 4 * 136) = pk2(a1.x, b1.x); *(LAS unsigned*)(dst + 5 * 136) = pk2(a1.y, b1.y); *(LAS unsigned*)(dst + 6 * 136) = pk2(a1.z, b1.z); *(LAS unsigned*)(dst + 7 * 136) = pk2(a1.w, b1.w); } }
            __syncthreads();
            u32x2 uR[2][4];
#pragma unroll
            for (int mm = 0; mm < 2; ++mm)
#pragma unroll
                for (int n = 0; n < 4; ++n) uR[mm][n] = *(const u32x2*)(ZB + (row0 + 32 * tb + 16 * mm + fr) * 2048 + g * 128 + 64 * db + 16 * n + 4 * fq);
            if (g + 1 < 8) SP_LOAD(g + 1);
            f32x4 acc[2][4];
#pragma unroll
            for (int mm = 0; mm < 2; ++mm)
#pragma unroll
                for (int n = 0; n < 4; ++n) acc[mm][n] = (f32x4){0.f, 0.f, 0.f, 0.f};
            for (int kk = 0; kk <= tb; ++kk) {
                bf16x8 Af[2], Xf[4];
#pragma unroll
                for (int mm = 0; mm < 2; ++mm) Af[mm] = *(const LAS bf16x8*)(Wc + (32 * tb + 16 * mm + fr) * 136 + 32 * kk + 8 * fq);
#pragma unroll
                for (int n = 0; n < 4; ++n) Xf[n] = *(const LAS bf16x8*)(vT + (64 * db + 16 * n + fr) * 136 + 32 * kk + 8 * fq);
#pragma unroll
                for (int mm = 0; mm < 2; ++mm)
#pragma unroll
                    for (int n = 0; n < 4; ++n) acc[mm][n] = __builtin_amdgcn_mfma_f32_16x16x32_bf16(Xf[n], Af[mm], acc[mm][n], 0, 0, 0);
            }
#pragma unroll
            for (int mm = 0; mm < 2; ++mm) { const int t = 32 * tb + 16 * mm + fr; const float bsv = bs[g * 128 + t];
#pragma unroll
                for (int n = 0; n < 4; ++n) { const int col = g * 128 + 64 * db + 16 * n + 4 * fq;
                    *(u32x2*)(GB + (row0 + t) * D + col) = pk4(unpk4(uR[mm][n]) * (acc[mm][n] + bsv)); } }
            __syncthreads();
        }
#undef SP_LOAD
    }
}

constexpr int SC_P64 = 72, SC_P32 = 40;
constexpr int SC_BKT = 0, SC_ART = 4608, SC_AJT = 9216, SC_BKH = 14336, SC_UV = 19456, SC_AHT = 22016, SC_INVT = 24320, SC_MB = 25600, SC_MITP = 26880, SC_PQT = 28160, SC_NF = SC_AHT  , SC_GC = 29440, SC_CH = 29696;
constexpr int SC_SB = 4 * SC_CH, SC_YB = SC_SB + 2 * 4608, SC_END = SC_YB + 8192;
static_assert(SC_END <= LDS_BYTES - 16, "scan LDS map");
__device__ __forceinline__ bf16x8 sc_frag(const LAS unsigned char* base, int pitch, int row, int k) { return *(const LAS bf16x8*)(base + (row * pitch + k) * 2); }
__device__ __forceinline__ void sc_st(LAS unsigned char* base, int idx, float v) { *(LAS __bf16*)(base + idx * 2) = (__bf16)v; }
__device__ __forceinline__ void sc_stf(LAS unsigned char* base, int idx, float v) { *(LAS unsigned short*)(base + idx * 2) = (unsigned short)pk2(v, v); }
__device__ __forceinline__ float sc_ld(const bf16* p) { return __uint_as_float((unsigned)(*p) << 16); }
constexpr int SC_SBP = 4 * SC_CH, SC_YB2 = SC_SBP + 2 * 2304, SC_END2 = SC_YB2 + 2 * 2048, SC_RAW = SC_END2, SC_ESUM = SC_RAW + 4 * 2 * 2560;
static_assert(SC_ESUM + 2048 <= LDS_BYTES - 16, "scan LDS map");
struct ScanCtx { const bf16 *R, *K, *V, *A, *E; bf16* Y; size_t tok0; int h, half, col, p4, hb; unsigned lane2, dmaoff; float kkc, kac; };
__device__ __forceinline__ float sc_ldl(const bf16* rowp, unsigned off2) { return __uint_as_float((unsigned)(*(const bf16*)((const char*)rowp + off2)) << 16); }
#define SC_DMA1(n_, sl_) do { const int nn_ = (n_) < SEQ / 16 ? (n_) : SEQ / 16 - 1; const size_t rb_ = (cx.tok0 + (size_t)nn_ * 16) * D + cx.hb; LAS unsigned char* rw_ = lds + SC_RAW + (wv - 2) * 5120 + (sl_) * 2560; \
            _Pragma("unroll") for (int sp = 0; sp < 2; ++sp) { const size_t ro_ = rb_ + (size_t)(cx.p4 + 2 * sp) * D; \
                __builtin_amdgcn_global_load_lds((const unsigned*)((const char*)(cx.E + ro_) + cx.dmaoff), (LAS unsigned*)(rw_ + (0 + sp) * 256), 4, 0, 0); \
                __builtin_amdgcn_global_load_lds((const unsigned*)((const char*)(cx.R + ro_) + cx.dmaoff), (LAS unsigned*)(rw_ + (2 + sp) * 256), 4, 0, 0); \
                __builtin_amdgcn_global_load_lds((const unsigned*)((const char*)(cx.K + ro_) + cx.dmaoff), (LAS unsigned*)(rw_ + (4 + sp) * 256), 4, 0, 0); \
                __builtin_amdgcn_global_load_lds((const unsigned*)((const char*)(cx.V + ro_) + cx.dmaoff), (LAS unsigned*)(rw_ + (6 + sp) * 256), 4, 0, 0); \
                __builtin_amdgcn_global_load_lds((const unsigned*)((const char*)(cx.A + ro_) + cx.dmaoff), (LAS unsigned*)(rw_ + (8 + sp) * 256), 4, 0, 0); } } while (0)
#define SC_ESUM1(m_) do { const LAS unsigned char* re_ = lds + SC_RAW + (wv - 2) * 5120 + ((m_) & 1) * 2560 + 2 * lane; \
            const float es_ = (SC_F((unsigned)*(const LAS unsigned short*)(re_)) + SC_F((unsigned)*(const LAS unsigned short*)(re_ + 128))) + (SC_F((unsigned)*(const LAS unsigned short*)(re_ + 256)) + SC_F((unsigned)*(const LAS unsigned short*)(re_ + 384))); \
            *(LAS float*)(lds + SC_ESUM + (((m_) & 1) * 4 + (wv - 2)) * 256 + 4 * lane) = es_; } while (0)
#define SC_RAWU(slot_, s_) ((unsigned)*(const LAS unsigned short*)(rw + ((slot_) + ((s_) >> 1)) * 256 + ((s_) & 1) * 128 + 2 * lane))
#define SC_F(u_) __uint_as_float((u_) << 16)
__device__ __forceinline__ void sc_tick(const int k, const int wv, LAS unsigned char* lds, const ScanCtx& cx, const f32x4 zero4, f32x4& St0, f32x4& St1, f32x4& St2, f32x4& St3, float (&X)[16]) {
    constexpr int NCH = SEQ / 16;
    const bf16* R = cx.R; const bf16* K = cx.K; const bf16* V = cx.V; const bf16* A = cx.A; const bf16* E = cx.E; bf16* Y = cx.Y;
    const size_t tok0 = cx.tok0; const int h = cx.h, half = cx.half, p4 = cx.p4; const float kkc = cx.kkc, kac = cx.kac;
    (void)R; (void)K; (void)V; (void)A; (void)E;
            const int lane = pg8::olane(), fr = lane & 15, fq = lane >> 4;
            if (wv < 2) {
                if (k >= 0 && k < NCH) {
                    LAS unsigned char* cb = lds + (k & 3) * SC_CH; LAS unsigned char* sbp = lds + SC_SBP + wv * 2304; const int r0 = 16 * wv;
                    const f32x4 Wt = __builtin_amdgcn_mfma_f32_16x16x32_bf16(sc_frag(cb + SC_UV, SC_P32, r0 + fr, 8 * fq), sc_frag(cb + SC_MITP, SC_P32, fr, 8 * fq), zero4, 0, 0, 0);
                    const bf16x8 x0 = sc_frag(sbp, SC_P64, fr, 8 * fq), x1 = sc_frag(sbp, SC_P64, fr, 32 + 8 * fq);
                    f32x4 u = __builtin_amdgcn_mfma_f32_16x16x32_bf16(x0, sc_frag(cb + SC_AHT, SC_P64, fr, 8 * fq), Wt, 0, 0, 0);
                    u = __builtin_amdgcn_mfma_f32_16x16x32_bf16(x1, sc_frag(cb + SC_AHT, SC_P64, fr, 32 + 8 * fq), u, 0, 0, 0);
#pragma unroll
                    for (int i = 0; i < 4; ++i) sc_st(cb + SC_UV, (r0 + 4 * fq + i) * SC_P32 + fr, u[i]);
                    f32x4 ya = __builtin_amdgcn_mfma_f32_16x16x32_bf16(x0, sc_frag(cb + SC_ART, SC_P64, 16 + fr, 8 * fq), zero4, 0, 0, 0);
                    ya = __builtin_amdgcn_mfma_f32_16x16x32_bf16(x1, sc_frag(cb + SC_ART, SC_P64, 16 + fr, 32 + 8 * fq), ya, 0, 0, 0);
                    asm volatile("s_waitcnt lgkmcnt(0)" ::: "memory");
                    const bf16x8 uv = sc_frag(cb + SC_UV, SC_P32, r0 + fr, 8 * fq);
                    ya = __builtin_amdgcn_mfma_f32_16x16x32_bf16(uv, sc_frag(cb + SC_PQT, SC_P32, fr, 8 * fq), ya, 0, 0, 0);
                    LAS float* yb = (LAS float*)(lds + SC_YB2 + (k & 1) * 2048);
#pragma unroll
                    for (int i = 0; i < 4; ++i) yb[fr * 32 + r0 + 4 * fq + i] = ya[i];
                    const LAS float* gcp = (const LAS float*)(cb + SC_GC);
                          St0 = __builtin_amdgcn_mfma_f32_16x16x32_bf16(uv, sc_frag(cb + SC_BKH, SC_P32, fr, 8 * fq), St0, 0, 0, 0); St0 = St0 * gcp[fr];
                     St1 = __builtin_amdgcn_mfma_f32_16x16x32_bf16(uv, sc_frag(cb + SC_BKH, SC_P32, 16 + fr, 8 * fq), St1, 0, 0, 0); St1 = St1 * gcp[16 + fr];
                     St2 = __builtin_amdgcn_mfma_f32_16x16x32_bf16(uv, sc_frag(cb + SC_BKH, SC_P32, 32 + fr, 8 * fq), St2, 0, 0, 0); St2 = St2 * gcp[32 + fr];
                     St3 = __builtin_amdgcn_mfma_f32_16x16x32_bf16(uv, sc_frag(cb + SC_BKH, SC_P32, 48 + fr, 8 * fq), St3, 0, 0, 0); St3 = St3 * gcp[48 + fr];
#pragma unroll
                    for (int i = 0; i < 4; ++i) { sc_st(sbp, (4 * fq + i) * SC_P64 + fr, St0[i]); sc_st(sbp, (4 * fq + i) * SC_P64 + 16 + fr, St1[i]); sc_st(sbp, (4 * fq + i) * SC_P64 + 32 + fr, St2[i]); sc_st(sbp, (4 * fq + i) * SC_P64 + 48 + fr, St3[i]); }
                    asm volatile("s_waitcnt lgkmcnt(0)" ::: "memory");
                }
            } else if (wv < 6) {
                const int n = k + 3;
                const LAS unsigned char* rw = lds + SC_RAW + (wv - 2) * 5120 + (n & 1) * 2560;
                unsigned pem[4], pr[4], pk[4], pv[4], pa[4];
#pragma unroll
                for (int s = 0; s < 4; ++s) { pem[s] = SC_RAWU(0, s); pr[s] = SC_RAWU(2, s); pk[s] = SC_RAWU(4, s); pv[s] = SC_RAWU(6, s); pa[s] = SC_RAWU(8, s); }
                float cum = 0.f;
#pragma unroll
                for (int q = 0; q < 3; ++q) { const float t_ = *(const LAS float*)(lds + SC_ESUM + ((n & 1) * 4 + q) * 256 + 4 * lane); cum += (4 * q < p4) ? t_ : 0.f; }
                asm volatile("s_waitcnt lgkmcnt(0)" ::: "memory");
                SC_DMA1(n + 2, n & 1);
                if (n < NCH) {
                    LAS unsigned char* cb = lds + (n & 3) * SC_CH;
                    float at4[4], nbh4[4], kh4[4];
#pragma unroll
                    for (int s = 0; s < 4; ++s) {
                        const int t = p4 + s; const float e = SC_F(pem[s]), pks = SC_F(pk[s]), pas = SC_F(pa[s]), prs = SC_F(pr[s]);
                        const float kkr = pks * kkc; const float n2 = wave_sum(kkr * kkr); const float kk = kkr * __builtin_amdgcn_rsqf(fmaxf(n2, 1e-24f));
                        const float kp = pks * ((pas - 1.0f) * kac + 1.0f), bb = kk * pas;
                        const float gprev = __expf(-cum); cum += e; const float gg = __expf(-cum), ginv = __builtin_amdgcn_rcpf(gg);
                        const float At = kk * gprev;
                        sc_stf(cb + SC_BKT, t * SC_P64 + lane, bb * ginv); sc_stf(cb + SC_BKT, (16 + t) * SC_P64 + lane, kp * ginv);
                        sc_stf(cb + SC_ART, t * SC_P64 + lane, At);        sc_stf(cb + SC_ART, (16 + t) * SC_P64 + lane, prs * gg);
                        at4[s] = At; nbh4[s] = -(bb * ginv); kh4[s] = kp * ginv;
                    }
                    u32x2 w2;
                    w2.x = pk2(at4[0], at4[1]); w2.y = pk2(at4[2], at4[3]);     *(LAS u32x2*)(cb + SC_AJT + (lane * SC_P32 + p4) * 2) = w2;
                    w2.x = pk2(nbh4[0], nbh4[1]); w2.y = pk2(nbh4[2], nbh4[3]); *(LAS u32x2*)(cb + SC_BKH + (lane * SC_P32 + p4) * 2) = w2;
                    w2.x = pk2(kh4[0], kh4[1]); w2.y = pk2(kh4[2], kh4[3]);     *(LAS u32x2*)(cb + SC_BKH + (lane * SC_P32 + 16 + p4) * 2) = w2;
                    if ((lane >> 5) == half) { w2.x = pv[0] | (pv[1] << 16); w2.y = pv[2] | (pv[3] << 16); *(LAS u32x2*)(cb + SC_UV + ((lane & 31) * SC_P32 + 16 + p4) * 2) = w2; }
                    if (p4 == 12) *(LAS float*)(cb + SC_GC + lane * 4) = __expf(-cum);
                }
                asm volatile("s_waitcnt vmcnt(10)" ::: "memory");
                SC_ESUM1(n + 1);
            } else if ((wv - 6) == (k & 1)) {
                const int n = k + 2;
                if (n >= 0 && n < NCH) {
                    LAS unsigned char* cb = lds + (n & 3) * SC_CH;
#pragma unroll
                    for (int q = 0; q < 4; ++q) { const int mt2 = q >> 1, nt2 = q & 1;
                        f32x4 acc = zero4;
#pragma unroll
                        for (int ks = 0; ks < 2; ++ks) acc = __builtin_amdgcn_mfma_f32_16x16x32_bf16(sc_frag(cb + SC_BKT, SC_P64, 16 * mt2 + fr, 32 * ks + 8 * fq), sc_frag(cb + SC_ART, SC_P64, 16 * nt2 + fr, 32 * ks + 8 * fq), acc, 0, 0, 0);
#pragma unroll
                        for (int i = 0; i < 4; ++i) { const int s = 4 * fq + i, t = fr; const float val = acc[i];
                            if (q == 0) *(LAS float*)(cb + SC_NF + (s * 16 + t) * 4) = s < t ? val : 0.f;
                            else if (q == 2) sc_st(cb + SC_MB, s * SC_P32 + t, s < t ? val : 0.f);
                            else if (q == 1) sc_st(cb + SC_PQT, t * SC_P32 + s, s <= t ? -val : 0.f);
                            else sc_st(cb + SC_PQT, t * SC_P32 + 16 + s, s <= t ? val : 0.f); } }
                    asm volatile("s_waitcnt lgkmcnt(0)" ::: "memory");
                    const LAS float* Nf = (const LAS float*)(cb + SC_NF);
                    X[15] = (fr == 15) ? 1.f : 0.f;
                    {   f32x4 Nq[12]; int idx = 0;
#pragma unroll
                        for (int s = 7; s < 15; ++s)
#pragma unroll
                            for (int q = (s + 1) / 4; q < 4; ++q) Nq[idx++] = *(const LAS f32x4*)(Nf + s * 16 + 4 * q);
                        __builtin_amdgcn_sched_barrier(0);
                        int base = 12;
#pragma unroll
                        for (int s = 14; s >= 7; --s) { const int q0 = (s + 1) / 4; base -= 4 - q0; float a = (s == fr) ? 1.f : 0.f;
#pragma unroll
                            for (int t = s + 1; t < 16; ++t) a -= Nq[base + t / 4 - q0][t & 3] * X[t];
                            X[s] = a; }
                    }
                }
                if (k >= 1 && k <= NCH) {
                    const LAS float* yb = (const LAS float*)(lds + SC_YB2 + ((k - 1) & 1) * 2048) + (lane >> 2) * 32 + 8 * (lane & 3);
                    const f32x4 y0 = *(const LAS f32x4*)yb, y1 = *(const LAS f32x4*)(yb + 4);
                    st8(Y + (tok0 + (size_t)(k - 1) * 16 + (lane >> 2)) * D + h * 64 + half * 32 + 8 * (lane & 3), y0, y1);
                }
            } else {
                const int n = k + 1;
                if (n >= 0 && n < NCH) {
                    LAS unsigned char* cb = lds + (n & 3) * SC_CH; const LAS float* Nf = (const LAS float*)(cb + SC_NF);
                    {   f32x4 Nq[24]; int idx = 0;
#pragma unroll
                        for (int s = 0; s < 7; ++s)
#pragma unroll
                            for (int q = (s + 1) / 4; q < 4; ++q) Nq[idx++] = *(const LAS f32x4*)(Nf + s * 16 + 4 * q);
                        __builtin_amdgcn_sched_barrier(0);
                        int base = 24;
#pragma unroll
                        for (int s = 6; s >= 0; --s) { const int q0 = (s + 1) / 4; base -= 4 - q0; float a = (s == fr) ? 1.f : 0.f;
#pragma unroll
                            for (int t = s + 1; t < 16; ++t) a -= Nq[base + t / 4 - q0][t & 3] * X[t];
                            X[s] = a; }
                    }
                    if (fq == 0) {
#pragma unroll
                        for (int s = 0; s < 16; s += 2) *(LAS unsigned*)(cb + SC_INVT + (fr * SC_P32 + s) * 2) = pk2(X[s], X[s + 1]); }
                    asm volatile("s_waitcnt lgkmcnt(0)" ::: "memory");
                    const bf16x8 iv = sc_frag(cb + SC_INVT, SC_P32, fr, 8 * fq);
#pragma unroll
                    for (int sub = 0; sub < 4; ++sub) { const f32x4 acc = __builtin_amdgcn_mfma_f32_16x16x32_bf16(iv, sc_frag(cb + SC_AJT, SC_P32, 16 * sub + fr, 8 * fq), zero4, 0, 0, 0);
#pragma unroll
                        for (int i = 0; i < 4; ++i) sc_st(cb + SC_AHT, (4 * fq + i) * SC_P64 + 16 * sub + fr, acc[i]); }
                    { const f32x4 acc = __builtin_amdgcn_mfma_f32_16x16x32_bf16(sc_frag(cb + SC_MB, SC_P32, fr, 8 * fq), iv, zero4, 0, 0, 0);
#pragma unroll
                      for (int i = 0; i < 4; ++i) sc_st(cb + SC_MITP, fr * SC_P32 + 16 + 4 * fq + i, acc[i]); }
                }
            }
}
__device__ __forceinline__ void ph_scan(const int wv, LAS unsigned char* lds, const bf16* R, const bf16* K, const bf16* V, const bf16* A, const bf16* E, bf16* Y, const float* k_k, const float* k_a) {
    const int lane = pg8::olane();
    float zf = 0.f; asm volatile("" : "+v"(zf));
    const f32x4 zero4 = (f32x4){zf, zf, zf, zf};
    constexpr int NCH = SEQ / 16;
    for (int unit = pg8::obid(); unit < NB * 32; unit += pg8::ogrid()) {
        ScanCtx cx; cx.R = R; cx.K = K; cx.V = V; cx.A = A; cx.E = E; cx.Y = Y;
        cx.h = (unit >> 1) & 15; cx.half = unit & 1; cx.tok0 = (size_t)(unit >> 5) * SEQ; cx.col = cx.h * 64 + lane; cx.p4 = 4 * (wv - 2); cx.hb = cx.h * 64; cx.lane2 = 2u * (unsigned)lane; cx.dmaoff = (unsigned)((lane >> 5) * D * 2 + (lane & 31) * 4);
        cx.kkc = k_k[cx.col]; cx.kac = k_a[cx.col];
        for (int i = (wv << 6) + lane; i < SC_END2 / 16; i += 512) ((LAS f32x4*)lds)[i] = zero4;
        __syncthreads();
        f32x4 St0 = zero4, St1 = zero4, St2 = zero4, St3 = zero4;
        float Xs[16];
#pragma unroll
        for (int i = 0; i < 16; ++i) Xs[i] = zf;
        if (wv >= 2 && wv < 6) { SC_DMA1(0, 0); SC_DMA1(1, 1); asm volatile("s_waitcnt vmcnt(10)" ::: "memory"); SC_ESUM1(0); }
        __syncthreads();
        for (int k = -3; k < NCH + 1; k += 2) {
            sc_tick(k, wv, lds, cx, zero4, St0, St1, St2, St3, Xs);
            __syncthreads();
            sc_tick(k + 1, wv, lds, cx, zero4, St0, St1, St2, St3, Xs);
            __syncthreads();
        }
        asm volatile("s_waitcnt vmcnt(0)" ::: "memory");
        __syncthreads();
    }
}
#undef SC_DMA1
#undef SC_ESUM1
#undef SC_RAWU
#undef SC_F

#define XB_TMO      128
#define XB_XCNT(j)  (256  + 64 * (j))
#define XB_XSUB(j)  (1280 + 64 * (j))
#define XB_XGEN(j)  (2304 + 64 * (j))
#define XB_TOP      3328
#define XB_TOPGEN   3392
#define XCD_BAR_WORDS 3456
#define XB_SPIN_CAP (1u << 18)

__device__ __forceinline__ unsigned xb_ld(unsigned* p)              { return __hip_atomic_load(p, __ATOMIC_RELAXED, __HIP_MEMORY_SCOPE_AGENT); }
__device__ __forceinline__ unsigned xb_add(unsigned* p, unsigned v) { return __hip_atomic_fetch_add(p, v, __ATOMIC_RELAXED, __HIP_MEMORY_SCOPE_AGENT); }
__device__ __forceinline__ unsigned xb_xcc_id() { return (unsigned)__builtin_amdgcn_s_getreg((3 << 11) | 20) & 0xFu; }
#define XB_SPIN(cond, bar) do { unsigned _sp = 0; while (cond) { __builtin_amdgcn_s_sleep(1); \
    if ((++_sp & 255u) == 0u) { if (xb_ld(&(bar)[XB_TMO])) break; if (_sp > XB_SPIN_CAP) { atomicAdd(&(bar)[XB_TMO], 1u); break; } } } } while (0)

struct XcdBarrier {
    unsigned* bar; unsigned x;
    volatile LAS unsigned* st;
};

__device__ __forceinline__ XcdBarrier xcd_barrier_post(unsigned* bar, volatile LAS unsigned* st, const bool t0) {
    XcdBarrier b; b.bar = bar; b.x = xb_xcc_id(); b.st = st;
    if (t0) (void)xb_add(&bar[XB_XCNT(b.x)], 1u);
    return b;
}
__device__ __forceinline__ void xcd_barrier_complete(unsigned* bar, unsigned x, unsigned& nloc, unsigned& nx) {
    const unsigned G = gridDim.x * gridDim.y * gridDim.z;
    unsigned sum, cnt, mine, sp = 0u;
    for (;;) {
        sum = 0u; cnt = 0u; mine = 0u;
#pragma unroll
        for (unsigned j = 0; j < 16; ++j) { const unsigned c = xb_ld(&bar[XB_XCNT(j)]); sum += c; cnt += (c > 0u) ? 1u : 0u; mine = (j == x) ? c : mine; }
        if (sum == G) break;
        __builtin_amdgcn_s_sleep(1);
        if ((++sp & 255u) == 0u) { if (xb_ld(&bar[XB_TMO])) break; if (sp > XB_SPIN_CAP) { atomicAdd(&bar[XB_TMO], 1u); break; } }
    }
    nloc = mine > 0u ? mine : 1u; nx = cnt > 0u ? cnt : 1u;
}

__device__ __forceinline__ void xcd_barrier(const XcdBarrier& b, const bool t0) {
    asm volatile("s_waitcnt vmcnt(0)" ::: "memory");
    __syncthreads();
    if (t0) {
        unsigned* bar = b.bar;
        __builtin_amdgcn_s_waitcnt(0);
        unsigned nloc = b.st[0], nx = b.st[1];
        if (nloc == 0u) { xcd_barrier_complete(bar, b.x, nloc, nx); b.st[0] = nloc; b.st[1] = nx; }
        const unsigned old = xb_add(&bar[XB_XSUB(b.x)], 1u);
        const unsigned gen = old / nloc;
        if (old + 1u == (gen + 1u) * nloc) {
            __builtin_amdgcn_fence(__ATOMIC_RELEASE, "agent");
            asm volatile("s_waitcnt vmcnt(0)" ::: "memory");
            const unsigned og = xb_add(&bar[XB_TOP], 1u);
            const unsigned tg = og / nx;
            if (og + 1u == (tg + 1u) * nx) xb_add(&bar[XB_TOPGEN], 1u);
            else XB_SPIN(xb_ld(&bar[XB_TOPGEN]) == tg, bar);
            __builtin_amdgcn_fence(__ATOMIC_ACQUIRE, "agent");
            xb_add(&bar[XB_XGEN(b.x)], 1u);
            asm volatile("s_waitcnt vmcnt(0)" ::: "memory");
        } else {
            XB_SPIN(xb_ld(&bar[XB_XGEN(b.x)]) == gen, bar);
            __builtin_amdgcn_fence(__ATOMIC_ACQUIRE, "agent");
            asm volatile("s_waitcnt vmcnt(0)" ::: "memory");
        }
    }
    __syncthreads();
}

#ifndef REP_SYNC
#define REP_SYNC 1
#endif
#ifndef REP_SCAN
#define REP_SCAN 1
#endif
#ifndef REP_F1
#define REP_F1 1
#endif
#ifndef REP_SPAT
#define REP_SPAT 1
#endif
#ifndef REP_MIX
#define REP_MIX 1
#endif
#ifndef REP_R1
#define REP_R1 1
#endif
#ifndef REP_G1
#define REP_G1 1
#endif
#ifndef REP_CONV
#define REP_CONV 1
#endif
#ifndef REP_EA
#define REP_EA 1
#endif
constexpr int XB_LDS_OFF = LDS_BYTES - 16;
#define GS() do { for (int r_ = 0; r_ < REP_SYNC; ++r_) { XcdBarrier xb_; xb_.bar = (unsigned*)WSB(0); xb_.x = xb_xcc_id(); xb_.st = (volatile LAS unsigned*)(lds + XB_LDS_OFF); xcd_barrier(xb_, pg8::otid(wv) == 0); } } while (0)
#define REPEAT(n) for (int r_ = 0; r_ < (n); ++r_)
__global__ void __launch_bounds__(512, 2) mega_fwd(Args a) {
    extern __shared__ __attribute__((aligned(16))) unsigned char lds_raw[];
    LAS unsigned char* lds = (LAS unsigned char*)lds_raw;
    cg::grid_group grid = cg::this_grid();
    const int wv = __builtin_amdgcn_readfirstlane((int)(threadIdx.x >> 6));

    { const int tid = pg8::otid(wv);
      if (pg8::obid() == 0) { unsigned* bw = (unsigned*)WSB(0); for (int i = tid; i < XCD_BAR_WORDS; i += 512) bw[i] = 0u; }
      if (tid < 2) ((volatile LAS unsigned*)(lds + XB_LDS_OFF))[tid] = 0u;
      __syncthreads(); }
    conv_layer(wv, 0, lds);
    ph_init_rows(wv, argp(0), HPTR, WSBF(WS_HB));
    grid.sync();
    (void)xcd_barrier_post((unsigned*)WSB(0), (volatile LAS unsigned*)(lds + XB_LDS_OFF), pg8::otid(wv) == 0);

#pragma unroll 1
    for (int layer = 0; layer < 4; ++layer) {
        const int j = layer >> 1;
        if ((layer & 1) == 0) {
            REPEAT(REP_G1) run_gemm<OpGelu, true>(wv, lds, WSBF(WS_HB), WSBF(WS_W + W_WIN), T, 2048, D, OpGelu{WSBF(WS_P)});
            GS();
            REPEAT(REP_SPAT) ph_spatial(wv, lds, WSBF(WS_P), WSBF(WS_P + 128 * MiB), WSBF(WS_W + W_WSC), argp(8) + j * D, argp(9) + j * D, argp(11) + j * 8 * 128);
            GS();
            run_gemm<OpResidB, true>(wv, lds, WSBF(WS_P + 128 * MiB), WSBF(WS_W + W_WOUT), T, D, D, OpResidB{WSBF(WS_HB)});
            GS();
        } else {
            const size_t offV = j ? P_S1 : WS_VF, offY = j ? WS_VF : P_S1;
#pragma unroll 1
            for (int q = 0; q < 4; ++q) {
                ph_mixprep(wv, WSBF(WS_HB), WSBF(P_S2), argp(13) + (size_t)j * 6 * D, q);
                GS();
                run_gemm<OpR1, true>(wv, lds, WSBF(P_S2), WSBF(WS_W + W_STK), 8192, (j ? 16 : 15) * 256, D, OpR1{RBUF, WSBF(P_S0), WSBF(offV), WSBF(P_LW), WSBF(P_LA), WSBF(P_LG), WSBF(P_LV)}, q * 8192, 0x3541333322220000ll, 32);
                GS();
            }
            if (j) run_gemm<OpVupd, true>(wv, lds, WSBF(P_LV), WSBF(WS_W + W_LV2), T, D, 128, OpVupd{WSBF(offV), WSBF(WS_VF), argp(29) + (size_t)(j - 1) * D});
            REPEAT(REP_EA) run_gemm<OpE, true>(wv, lds, WSBF(P_LW), WSBF(WS_W + W_LW2), T, D, 128, OpE{WSBF(P_S3), argp(15) + (size_t)j * D});
            run_gemm<OpA, true>(wv, lds, WSBF(P_LA), WSBF(WS_W + W_LA2), T, D, 128, OpA{WSBF(P_S2), argp(18) + (size_t)j * D});
            GS();
            REPEAT(REP_SCAN) ph_scan(wv, lds, RBUF, WSBF(P_S0), WSBF(offV), WSBF(P_S2), WSBF(P_S3), WSBF(offY), argp(23) + (size_t)j * D, argp(24) + (size_t)j * D);
            GS();
            ph_post(wv, WSBF(offY), RBUF, WSBF(P_S0), WSBF(offV), WSBF(P_S2), argp(24) + (size_t)j * D, argp(25) + (size_t)j * D, argp(26) + (size_t)j * D, argp(27) + (size_t)j * D);
            GS();
            run_gemm<OpG, true>(wv, lds, WSBF(P_LG), WSBF(WS_W + W_LG2), T, D, 256, OpG{WSBF(P_S3), WSBF(offY)});
            GS();
            run_gemm<OpResidB, true>(wv, lds, WSBF(P_S3), WSBF(WS_W + W_WO), T, D, D, OpResidB{WSBF(WS_HB)});
            GS();
        }
        ph_ln(wv, HPTR, WSBF(WS_HB), argp(1) + (size_t)layer * D, argp(2) + (size_t)layer * D, false, false, true);
        GS();
        REPEAT(REP_F1) run_gemm<OpRelu2, true>(wv, lds, WSBF(WS_HB), WSBF(WS_W + W_W1), T, FF, D, OpRelu2{WSBF(WS_P)});
        GS();
        if (layer < 3) run_gemm<OpResidB, true>(wv, lds, WSBF(WS_P), WSBF(WS_W + W_W2), T, D, FF, OpResidB{WSBF(WS_HB)});
        else run_gemm<OpResidF, true>(wv, lds, WSBF(WS_P), WSBF(WS_W + W_W2), T, D, FF, OpResidF{HPTR, WSBF(WS_HB)});
        GS();
        ph_ln(wv, HPTR, WSBF(WS_HB), argp(3) + (size_t)layer * D, argp(4) + (size_t)layer * D, layer == 3, layer == 3, layer != 3);
        if (layer < 3) REPEAT(REP_CONV) conv_layer(wv, layer + 1, lds);
        GS();
    }
}

extern "C" void kernel_launch(void* const* d_in, const int* in_sizes, int n_in, void* d_out, int out_size, void* d_ws, size_t ws_size, hipStream_t stream) {
    static int grid = 0;
    if (grid == 0) {
        int dev = 0, cus = 0, per_cu = 0;
        hipGetDevice(&dev);
        hipDeviceGetAttribute(&cus, hipDeviceAttributeMultiprocessorCount, dev);
        hipFuncSetAttribute((const void*)mega_fwd, hipFuncAttributeMaxDynamicSharedMemorySize, LDS_BYTES);
        hipOccupancyMaxActiveBlocksPerMultiprocessor(&per_cu, (const void*)mega_fwd, 512, LDS_BYTES);
        (void)hipGetLastError();
        if (per_cu < 1) per_cu = 1;
        if (cus < 1) cus = 256;
        grid = cus * per_cu;
        if (n_in != 32 || ws_size < 512 * MiB) fprintf(stderr, "kernel_launch: unexpected n_in %d / ws_size %zu\n", n_in, ws_size);
    }
    Args a{};
    for (int i = 0; i < 32; ++i) a.in[i] = (const float*)d_in[i];
    a.out = (float*)d_out; a.ws = (unsigned char*)d_ws;
    void* args[] = {&a};
    hipError_t e = hipLaunchCooperativeKernel((const void*)mega_fwd, dim3(grid), dim3(512), args, LDS_BYTES, stream);
    if (e != hipSuccess) fprintf(stderr, "cooperative launch failed: %s (grid %d)\n", hipGetErrorString(e), grid);
}
```

```cpp
#include <hip/hip_runtime.h>
#include <hip/hip_cooperative_groups.h>
#include <cstdio>
#include <cstdint>
namespace pg8 {
#define PG8_LAS __attribute__((address_space(3)))
typedef unsigned short bf16_t;
typedef short bf16x8 __attribute__((ext_vector_type(8)));
typedef float f32x4 __attribute__((ext_vector_type(4)));
typedef unsigned u32x4 __attribute__((ext_vector_type(4)));
constexpr int BM = 256, BK = 64, HALF = 128, HTB = HALF * BK * 2  , STAGE_BYTES = 8 * HTB, NXCD = 8, WGM = 8;

__host__ __device__ __forceinline__ int lds_byte(int r, int c) { const int st = (r >> 4) * 2 + (c >> 5), rr = r & 15, cc = c & 31, ob = rr * 64 + cc * 2; return st * 1024 + (ob ^ (((ob >> 9) & 1) << 5)); }
__host__ __device__ __forceinline__ void stage_rc(int b, int& R, int& C) { const int st = b / 1024, sb = b % 1024, swz = sb ^ (((sb >> 9) & 1) << 5); R = (st >> 1) * 16 + swz / 64; C = (st & 1) * 32 + (swz % 64) / 2; }
__host__ __device__ __forceinline__ int perm32(int rho) { const int n = rho >> 4, i = rho & 15; return 8 * (i >> 2) + 4 * n + (i & 3); }

__device__ __forceinline__ int olane() { unsigned ones = ~0u; asm volatile("" : "+s"(ones)); return (int)__builtin_amdgcn_mbcnt_hi(ones, __builtin_amdgcn_mbcnt_lo(ones, 0u)); }
__device__ __forceinline__ int otid(int wv) { return (wv << 6) | olane(); }
__device__ __forceinline__ int obid() { int b = blockIdx.x; asm volatile("" : "+s"(b)); return b; }
__device__ __forceinline__ int ogrid() { int g = gridDim.x; asm volatile("" : "+s"(g)); return g; }
struct Unit { int pm, pn, pa; };
struct Gemm { const bf16_t* A; const bf16_t* Bt; int M, N, K; };

struct StaticOrder {
    int nM, nN, nwg, G, c; long long amap; int apan;
    __host__ __device__ void init(int M, int N, int G_, int c_) { nM = M / BM; nN = N / BM; nwg = nM * nN; G = G_; c = c_; amap = 0; apan = 0; }
    __host__ __device__ bool next(int i, Unit& u) const {
        const long L = (long)i * G + c; if (L >= nwg) return false;
        int wgid = (int)L; { const int q = nwg / NXCD, r = nwg % NXCD, xcd = wgid % NXCD, off = wgid / NXCD; wgid = (xcd < r ? xcd * (q + 1) : r * (q + 1) + (xcd - r) * q) + off; }
        const int nig = WGM * nN, gid = wgid / nig, fm = gid * WGM, gsz = (nM - fm) < WGM ? (nM - fm) : WGM;
        u.pm = fm + ((wgid % nig) % gsz); u.pn = (wgid % nig) / gsz; u.pa = (int)((amap >> (4 * u.pn)) & 15) * apan + u.pm; return true;
    }
    __device__ __forceinline__ void a_ready(const Unit&) const {}
    __device__ __forceinline__ void done(const Unit&) const {}
};

typedef __bf16 bf16x2_native __attribute__((ext_vector_type(2)));
typedef float f32x2_cvt __attribute__((ext_vector_type(2)));
__device__ __forceinline__ unsigned cvt_pk_bf16(float lo, float hi) { const f32x2_cvt v = {lo, hi}; return __builtin_bit_cast(unsigned, __builtin_convertvector(v, bf16x2_native)); }
typedef float f32x2 __attribute__((ext_vector_type(2)));
__device__ __forceinline__ f32x2 gelu_pk(f32x2 v) {
    const f32x2 av = __builtin_elementwise_abs(v), d = av * 0.2316418882f + 1.0f;
    f32x2 t; t.x = __builtin_amdgcn_rcpf(d.x); t.y = __builtin_amdgcn_rcpf(d.y);
    f32x2 q = t * 0.5307027145f + (-0.7265760135f); q = q * t + 0.7107068705f; q = q * t + (-0.142248368f); q = q * t + 0.127414796f; q = q * t;
    const f32x2 s = (v * v) * (-0.72134752044f);
    f32x2 e; e.x = __builtin_amdgcn_exp2f(s.x); e.y = __builtin_amdgcn_exp2f(s.y);
    const f32x2 m = v * (q * e), r = v - m;
    f32x2 o; o.x = v.x < 0.f ? m.x : r.x; o.y = v.y < 0.f ? m.y : r.y; return o;
}

template <class Epi, class Sched, bool ALIGN_EPI = false, bool SP2 = false>
__device__ __forceinline__ void gemm_phase(PG8_LAS unsigned char* lds, const Gemm g, const Sched& S, const Epi& E, const int wv) {
    const int tid = otid(wv), wid = __builtin_amdgcn_readfirstlane(tid >> 6), lane = tid & 63, wr = wid >> 2, wc = wid & 3, fr = lane & 15, fq = lane >> 4;
    const int K = g.K, nt = K / BK;
    unsigned voffA[2], voffB[2];
#pragma unroll
    for (int i = 0; i < 2; ++i) { int R, C; stage_rc(tid * 16 + i * 8192, R, C); const int Rb = Epi::PERM ? ((R & ~31) + perm32(R & 31)) : R;
        voffA[i] = (unsigned)(R * K + C) * 2u; voffB[i] = (unsigned)(Rb * K + C) * 2u; }
    const size_t kstep = (size_t)(BK * 2);
    const size_t hstep = (size_t)HALF * K * 2;
    const size_t tstep = 2 * hstep;
    const unsigned ldsw = (unsigned)wid * 1024u;
    const int aoff = lds_byte(wr * 64 + fr, fq * 8), boff = lds_byte(wc * 32 + fr, fq * 8);
#define PG8_SA(b, h) (((b) * 2 + (h)) * HTB)
#define PG8_SB(b, h) ((4 + (b) * 2 + (h)) * HTB)
#define PG8_STAGE(bufoff, gbase, voff) do { _Pragma("unroll") for (int _i = 0; _i < 2; ++_i) \
        __builtin_amdgcn_global_load_lds((const unsigned*)((const char*)(gbase) + (voff)[_i]), (PG8_LAS unsigned*)(lds + (bufoff) + ldsw + _i * 8192), 16, 0, 0); } while (0)
#define PG8_LDA(dst, b, h) do { _Pragma("unroll") for (int m = 0; m < 4; ++m) _Pragma("unroll") for (int k = 0; k < 2; ++k) dst[m][k] = *(const PG8_LAS bf16x8*)(lds + PG8_SA(b, h) + aoff + m * 2048 + k * 1024); } while (0)
#define PG8_LDB(dst, b, h) do { _Pragma("unroll") for (int n = 0; n < 2; ++n) _Pragma("unroll") for (int k = 0; k < 2; ++k) dst[n][k] = *(const PG8_LAS bf16x8*)(lds + PG8_SB(b, h) + boff + n * 2048 + k * 1024); } while (0)
#define PG8_MMA(ai, bj, At, Bt) do { __builtin_amdgcn_s_setprio(1); _Pragma("unroll") for (int m = 0; m < 4; ++m) _Pragma("unroll") for (int n = 0; n < 2; ++n) _Pragma("unroll") for (int k = 0; k < 2; ++k) \
        acc[ai][bj][m][n] = __builtin_amdgcn_mfma_f32_16x16x32_bf16(Bt[n][k], At[m][k], acc[ai][bj][m][n], 0, 0, 0); __builtin_amdgcn_s_setprio(0); } while (0)
#define PG8_WAIT_V(n) asm volatile("s_waitcnt vmcnt(" #n ")" ::: "memory")
#define PG8_WAIT_L(n) asm volatile("s_waitcnt lgkmcnt(" #n ")" ::: "memory")
#define PG8_BAR __builtin_amdgcn_s_barrier()
#define PG8_SCHED __builtin_amdgcn_sched_barrier(0)
    Unit cur, nxt; int ui = 0;
    if (!S.next(0, cur)) return;
    f32x4 acc[2][2][4][2];
#pragma unroll
    for (int a = 0; a < 2; ++a)
#pragma unroll
        for (int b = 0; b < 2; ++b)
#pragma unroll
            for (int m = 0; m < 4; ++m)
#pragma unroll
                for (int n = 0; n < 2; ++n) acc[a][b][m][n] = (f32x4){0.f, 0.f, 0.f, 0.f};
    bf16x8 At[4][2], B0[2][2], B1[2][2];
    const char* cA = (const char*)g.A + (size_t)cur.pa * tstep; const char* cB = (const char*)g.Bt + (size_t)cur.pn * tstep;
    S.a_ready(cur);
    if constexpr (SP2) {
        PG8_STAGE(PG8_SB(0, 0), cB, voffB); PG8_STAGE(PG8_SB(0, 1), cB + hstep, voffB); PG8_STAGE(PG8_SA(0, 0), cA, voffA); PG8_STAGE(PG8_SA(0, 1), cA + hstep, voffA);
        if (wr == 1) PG8_BAR;
        PG8_WAIT_V(2); PG8_BAR;
        PG8_STAGE(PG8_SB(1, 0), cB + kstep, voffB); PG8_STAGE(PG8_SA(1, 0), cA + kstep, voffA); PG8_STAGE(PG8_SB(1, 1), cB + hstep + kstep, voffB);
        PG8_WAIT_V(6); PG8_BAR;
    } else {
        PG8_STAGE(PG8_SB(0, 0), cB, voffB); PG8_STAGE(PG8_SA(0, 0), cA, voffA); PG8_STAGE(PG8_SB(0, 1), cB + hstep, voffB); PG8_STAGE(PG8_SA(0, 1), cA + hstep, voffA);
        if (wr == 1) PG8_BAR;
        PG8_WAIT_V(4); PG8_BAR;
        PG8_STAGE(PG8_SB(1, 0), cB + kstep, voffB); PG8_STAGE(PG8_SA(1, 0), cA + kstep, voffA); PG8_STAGE(PG8_SB(1, 1), cB + hstep + kstep, voffB);
        PG8_WAIT_V(6); PG8_BAR;
    }
    for (;;) {
        const bool has_next = S.next(ui + 1, nxt);
        const char* nA = has_next ? (const char*)g.A + (size_t)nxt.pa * tstep : cA; const char* nB = has_next ? (const char*)g.Bt + (size_t)nxt.pn * tstep : cB;
        for (int t = 0; t < nt; t += 2) {
            const bool last = (t == nt - 2);
            const char* a1 = cA + (size_t)(t + 1) * kstep;
            const char* a2 = last ? nA : cA + (size_t)(t + 2) * kstep; const char* b2 = last ? nB : cB + (size_t)(t + 2) * kstep;
            const char* a3 = a2 + kstep; const char* b3 = b2 + kstep;
            if (last && has_next) S.a_ready(nxt);
            if constexpr (SP2) {
            PG8_LDB(B0, 0, 0); PG8_LDB(B1, 0, 1); PG8_SCHED; PG8_LDA(At, 0, 0); PG8_STAGE(PG8_SA(1, 1), a1 + hstep, voffA);
            PG8_WAIT_V(8); PG8_WAIT_L(0); PG8_BAR; PG8_MMA(0, 0, At, B0); PG8_MMA(0, 1, At, B1); PG8_BAR; PG8_SCHED;
            PG8_LDA(At, 0, 1); PG8_STAGE(PG8_SB(0, 0), b2, voffB); PG8_STAGE(PG8_SB(0, 1), b2 + hstep, voffB); PG8_STAGE(PG8_SA(0, 0), a2, voffA);
            PG8_WAIT_V(8); PG8_WAIT_L(0); PG8_BAR; PG8_MMA(1, 0, At, B0); PG8_MMA(1, 1, At, B1); PG8_BAR; PG8_SCHED;
            PG8_LDB(B0, 1, 0); PG8_LDB(B1, 1, 1); PG8_SCHED; PG8_LDA(At, 1, 0); PG8_STAGE(PG8_SA(0, 1), a2 + hstep, voffA);
            PG8_WAIT_V(8); PG8_WAIT_L(0); PG8_BAR; PG8_MMA(0, 0, At, B0); PG8_MMA(0, 1, At, B1); PG8_BAR; PG8_SCHED;
            PG8_LDA(At, 1, 1); PG8_STAGE(PG8_SB(1, 0), b3, voffB); PG8_STAGE(PG8_SB(1, 1), b3 + hstep, voffB); PG8_STAGE(PG8_SA(1, 0), a3, voffA);
            PG8_WAIT_V(8); PG8_WAIT_L(0); PG8_BAR; PG8_MMA(1, 0, At, B0); PG8_MMA(1, 1, At, B1); PG8_BAR; PG8_SCHED;
            } else {
            PG8_LDB(B0, 0, 0); PG8_SCHED; PG8_LDA(At, 0, 0); PG8_STAGE(PG8_SA(1, 1), a1 + hstep, voffA);
            PG8_WAIT_L(8); PG8_BAR; PG8_WAIT_L(0); PG8_MMA(0, 0, At, B0); PG8_BAR; PG8_SCHED;
            PG8_LDB(B1, 0, 1); PG8_STAGE(PG8_SB(0, 0), b2, voffB);
            PG8_BAR; PG8_WAIT_L(0); PG8_MMA(0, 1, At, B1); PG8_BAR;
            PG8_LDA(At, 0, 1); PG8_STAGE(PG8_SA(0, 0), a2, voffA);
            PG8_BAR; PG8_WAIT_L(0); PG8_MMA(1, 0, At, B0); PG8_BAR; PG8_SCHED;
            PG8_STAGE(PG8_SB(0, 1), b2 + hstep, voffB);
            PG8_WAIT_V(6); PG8_BAR; PG8_MMA(1, 1, At, B1); PG8_BAR;
            PG8_LDB(B0, 1, 0); PG8_SCHED; PG8_LDA(At, 1, 0); PG8_STAGE(PG8_SA(0, 1), a2 + hstep, voffA);
            PG8_WAIT_L(8); PG8_BAR; PG8_WAIT_L(0); PG8_MMA(0, 0, At, B0); PG8_BAR; PG8_SCHED;
            PG8_LDB(B1, 1, 1); PG8_STAGE(PG8_SB(1, 0), b3, voffB);
            PG8_BAR; PG8_WAIT_L(0); PG8_MMA(0, 1, At, B1); PG8_BAR;
            PG8_LDA(At, 1, 1); PG8_STAGE(PG8_SA(1, 0), a3, voffA);
            PG8_BAR; PG8_WAIT_L(0); PG8_MMA(1, 0, At, B0); PG8_BAR; PG8_SCHED;
            PG8_STAGE(PG8_SB(1, 1), b3 + hstep, voffB);
            PG8_WAIT_V(6); PG8_BAR; PG8_MMA(1, 1, At, B1); PG8_BAR;
            }
        }
        if constexpr (ALIGN_EPI) { if (wr == 0) PG8_BAR; }
        if constexpr (!Epi::AFTER_DRAIN) { E(acc, cur, wr, wc, fr, fq); S.done(cur); }
        if (!has_next) break;
#pragma unroll
        for (int a = 0; a < 2; ++a)
#pragma unroll
            for (int b = 0; b < 2; ++b)
#pragma unroll
                for (int m = 0; m < 4; ++m)
#pragma unroll
                    for (int n = 0; n < 2; ++n) acc[a][b][m][n] = (f32x4){0.f, 0.f, 0.f, 0.f};
        cur = nxt; cA = nA; cB = nB; ++ui;
        if constexpr (ALIGN_EPI) { if (wr == 1) PG8_BAR; }
    }
    PG8_WAIT_V(0);
    if constexpr (!ALIGN_EPI) { if (wr == 0) PG8_BAR; }
    PG8_BAR;
    if constexpr (Epi::AFTER_DRAIN) { E.fused(acc, cur, wr, wc, fr, fq, lds, wid, lane); S.done(cur); }
#undef PG8_SA
#undef PG8_SB
#undef PG8_STAGE
#undef PG8_LDA
#undef PG8_LDB
#undef PG8_MMA
#undef PG8_WAIT_V
#undef PG8_WAIT_L
#undef PG8_BAR
#undef PG8_SCHED
}
}

namespace cg = cooperative_groups;
#define LAS __attribute__((address_space(3)))
typedef unsigned short bf16;
typedef float f32x4 __attribute__((ext_vector_type(4)));
typedef float f32x2 __attribute__((ext_vector_type(2)));
typedef unsigned u32x4 __attribute__((ext_vector_type(4)));
typedef unsigned u32x2 __attribute__((ext_vector_type(2)));
typedef short bf16x8 __attribute__((ext_vector_type(8)));

constexpr int NB = 8, SEQ = 4096, T = NB * SEQ, D = 1024, FF = 4096;
constexpr float ALPHA = 1.681792830507429f;
constexpr float LN_EPS = 1e-5f, GN_EPS = 64e-5f;
constexpr int LDS_BYTES = 155648;
constexpr size_t MiB = 1u << 20;
constexpr size_t WS_W = 4 * MiB, WS_HB = 32 * MiB, WS_VF = 96 * MiB, WS_P = 160 * MiB;
constexpr size_t W_WIN = 0, W_WOUT = 4 * MiB, W_WSC = 6 * MiB;
constexpr size_t W_STK = 0, W_WO = 8 * MiB, W_LW2 = 10 * MiB, W_LA2 = 10 * MiB + 256 * 1024, W_LV2 = 10 * MiB + 512 * 1024, W_LG2 = 10 * MiB + 768 * 1024;
constexpr size_t W_W1 = 12 * MiB, W_W2 = 20 * MiB;
constexpr size_t P_S0 = WS_P, P_S1 = WS_P + 64 * MiB, P_S2 = WS_P + 128 * MiB, P_S3 = WS_P + 192 * MiB;
constexpr size_t P_LW = WS_P + 256 * MiB, P_LA = WS_P + 264 * MiB, P_LV = WS_P + 272 * MiB, P_LG = WS_P + 280 * MiB;

struct Args { const float* in[32]; float* out; unsigned char* ws; };
__device__ __forceinline__ const float* argp(int i) {
    const __attribute__((address_space(4))) unsigned char* k = (const __attribute__((address_space(4))) unsigned char*)__builtin_amdgcn_kernarg_segment_ptr();
    int off = i * 8; asm volatile("" : "+s"(off));
    return *(const float* const __attribute__((address_space(4)))*)(k + off);
}

__device__ __forceinline__ unsigned pk2(float lo, float hi) { return pg8::cvt_pk_bf16(lo, hi); }
__device__ __forceinline__ float bflo(unsigned w) { return __uint_as_float(w << 16); }
__device__ __forceinline__ float bfhi(unsigned w) { return __uint_as_float(w & 0xffff0000u); }
__device__ __forceinline__ f32x4 unpk4(u32x2 w) { return (f32x4){bflo(w.x), bfhi(w.x), bflo(w.y), bfhi(w.y)}; }
__device__ __forceinline__ u32x2 pk4(f32x4 v) { u32x2 w; w.x = pk2(v.x, v.y); w.y = pk2(v.z, v.w); return w; }
__device__ __forceinline__ void st8(bf16* p, f32x4 a, f32x4 b) { u32x4 w; w.x = pk2(a.x, a.y); w.y = pk2(a.z, a.w); w.z = pk2(b.x, b.y); w.w = pk2(b.z, b.w); *(u32x4*)p = w; }
__device__ __forceinline__ void ld8(const bf16* p, f32x4& a, f32x4& b) { const u32x4 w = *(const u32x4*)p; a = (f32x4){bflo(w.x), bfhi(w.x), bflo(w.y), bfhi(w.y)}; b = (f32x4){bflo(w.z), bfhi(w.z), bflo(w.w), bfhi(w.w)}; }
__device__ __forceinline__ float sigm(float x) { return __builtin_amdgcn_rcpf(1.0f + __expf(-x)); }
__device__ __forceinline__ f32x4 sigm4(f32x4 v) { return (f32x4){sigm(v.x), sigm(v.y), sigm(v.z), sigm(v.w)}; }
__device__ __forceinline__ float tanh_f(float x) { return 1.0f - 2.0f * __builtin_amdgcn_rcpf(1.0f + __expf(2.0f * x)); }
__device__ __forceinline__ f32x4 tanh4(f32x4 v) { return (f32x4){tanh_f(v.x), tanh_f(v.y), tanh_f(v.z), tanh_f(v.w)}; }
__device__ __forceinline__ f32x4 gelu4(f32x4 v) { const f32x2 a = pg8::gelu_pk((f32x2){v.x, v.y}), b = pg8::gelu_pk((f32x2){v.z, v.w}); return (f32x4){a.x, a.y, b.x, b.y}; }
template <int CTRL> __device__ __forceinline__ float dppf(float x) { return __builtin_bit_cast(float, __builtin_amdgcn_update_dpp(0, __builtin_bit_cast(int, x), CTRL, 0xF, 0xF, true)); }
__device__ __forceinline__ float red16(float x) { x += dppf<0xB1>(x); x += dppf<0x4E>(x); x += dppf<0x141>(x); x += dppf<0x140>(x); return x; }
__device__ __forceinline__ float wave_sum(float v) { const float r = red16(v); const int ri = __builtin_bit_cast(int, r);
    return (__builtin_bit_cast(float, __builtin_amdgcn_readlane(ri, 0)) + __builtin_bit_cast(float, __builtin_amdgcn_readlane(ri, 16))) + (__builtin_bit_cast(float, __builtin_amdgcn_readlane(ri, 32)) + __builtin_bit_cast(float, __builtin_amdgcn_readlane(ri, 48))); }
__device__ __forceinline__ float sum4(f32x4 v) { return (v.x + v.y) + (v.z + v.w); }

#define WSB(off) ((unsigned char*)argp(33) + (off))
#define WSBF(off) ((bf16*)WSB(off))
#define HPTR ((float*)argp(32))
#define RBUF ((bf16*)argp(32))
template <class Op> struct Epi8 {
    static constexpr bool PERM = true, AFTER_DRAIN = false;
    Op op; int row_off;
    __device__ __forceinline__ void operator()(const f32x4 (&acc)[2][2][4][2], const pg8::Unit& u, int wr, int wc, int, int) const {
        const int lane_ = pg8::olane();
        const int fr = lane_ & 15, fq = lane_ >> 4;
        const int row0 = row_off + u.pm * 256 + wr * 64 + fr, colb = wc * 32 + 8 * fq;
        if constexpr (Op::PRE) {
#pragma unroll
            for (int ai = 0; ai < 2; ++ai) {
                typename Op::PreT pre[4][2];
#pragma unroll
                for (int m = 0; m < 4; ++m)
#pragma unroll
                    for (int bj = 0; bj < 2; ++bj) pre[m][bj] = op.pre(row0 + ai * 128 + m * 16, u.pn, bj * 128 + colb);
#pragma unroll
                for (int m = 0; m < 4; ++m)
#pragma unroll
                    for (int bj = 0; bj < 2; ++bj) op.post(row0 + ai * 128 + m * 16, u.pn, bj * 128 + colb, acc[ai][bj][m][0], acc[ai][bj][m][1], pre[m][bj]);
                asm volatile("" ::: "memory");
            }
        } else {
#pragma unroll
            for (int ai = 0; ai < 2; ++ai)
#pragma unroll
                for (int m = 0; m < 4; ++m)
                {
#pragma unroll
                    for (int bj = 0; bj < 2; ++bj) op(row0 + ai * 128 + m * 16, u.pn, bj * 128 + colb, acc[ai][bj][m][0], acc[ai][bj][m][1]);
                    asm volatile("" ::: "memory");
                }
        }
    }
};
__device__ __forceinline__ void unpk8(u32x4 w, f32x4& a, f32x4& b) { a = (f32x4){bflo(w.x), bfhi(w.x), bflo(w.y), bfhi(w.y)}; b = (f32x4){bflo(w.z), bfhi(w.z), bflo(w.w), bfhi(w.w)}; }
struct OpGelu { static constexpr bool PRE = false; bf16* O;
    __device__ __forceinline__ void operator()(int row, int pn, int ct, f32x4 v0, f32x4 v1) const { st8(O + (size_t)row * 2048 + pn * 256 + ct, gelu4(v0), gelu4(v1)); } };
struct OpRelu2 { static constexpr bool PRE = false; bf16* O;
    __device__ __forceinline__ void operator()(int row, int pn, int ct, f32x4 v0, f32x4 v1) const {
        v0 = __builtin_elementwise_max(v0, (f32x4){0.f, 0.f, 0.f, 0.f}); v1 = __builtin_elementwise_max(v1, (f32x4){0.f, 0.f, 0.f, 0.f});
        st8(O + (size_t)row * FF + pn * 256 + ct, v0 * v0, v1 * v1); } };
struct OpResid { static constexpr bool PRE = false; float* H;
    __device__ __forceinline__ void operator()(int row, int pn, int ct, f32x4 v0, f32x4 v1) const {
        float* p = H + (size_t)row * D + pn * 256 + ct; const f32x4 a = *(const f32x4*)p, b = *(const f32x4*)(p + 4);
        *(f32x4*)p = a * ALPHA + v0; *(f32x4*)(p + 4) = b * ALPHA + v1; } };
struct OpResidB { static constexpr bool PRE = true; typedef u32x4 PreT; bf16* HB;
    __device__ __forceinline__ u32x4 pre(int row, int pn, int ct) const { return *(const u32x4*)(HB + (size_t)row * D + pn * 256 + ct); }
    __device__ __forceinline__ void post(int row, int pn, int ct, f32x4 v0, f32x4 v1, u32x4 p) const { f32x4 a, b; unpk8(p, a, b); st8(HB + (size_t)row * D + pn * 256 + ct, a * ALPHA + v0, b * ALPHA + v1); } };
struct OpResidF { static constexpr bool PRE = true; typedef u32x4 PreT; float* Y; const bf16* HB;
    __device__ __forceinline__ u32x4 pre(int row, int pn, int ct) const { return *(const u32x4*)(HB + (size_t)row * D + pn * 256 + ct); }
    __device__ __forceinline__ void post(int row, int pn, int ct, f32x4 v0, f32x4 v1, u32x4 p) const { const size_t off = (size_t)row * D + pn * 256 + ct; f32x4 a, b; unpk8(p, a, b);
        *(f32x4*)(Y + off) = a * ALPHA + v0; *(f32x4*)(Y + off + 4) = b * ALPHA + v1; } };
struct OpR1 { static constexpr bool PRE = false; bf16 *R, *K, *V, *LW, *LA, *LG, *LV;
    __device__ __forceinline__ void operator()(int row, int pn, int ct, f32x4 v0, f32x4 v1) const {
        const f32x4 z = (f32x4){0.f, 0.f, 0.f, 0.f};
        if (pn < 12) { const long long dK = (const char*)K - (const char*)R, dV = (const char*)V - (const char*)R;
            bf16* base = (bf16*)((char*)R + ((pn >= 4 && pn < 8) ? dK : 0ll) + (pn >= 8 ? dV : 0ll)); st8(base + (size_t)row * D + (pn & 3) * 256 + ct, v0, v1); }
        else if (pn == 12) { if (ct < 128) { if (ct < 64) { v0 = tanh4(v0); v1 = tanh4(v1); } else { v0 = z; v1 = z; } st8(LW + (size_t)row * 128 + ct, v0, v1); } }
        else if (pn == 13) { if (ct < 128) { if (ct >= 64) { v0 = z; v1 = z; } st8(LA + (size_t)row * 128 + ct, v0, v1); } }
        else if (pn == 14) { if (ct < 160) { v0 = sigm4(v0); v1 = sigm4(v1); } else { v0 = z; v1 = z; } st8(LG + (size_t)row * 256 + ct, v0, v1); }
        else { if (ct < 128) { if (ct >= 32) { v0 = z; v1 = z; } st8(LV + (size_t)row * 128 + ct, v0, v1); } }
    } };
struct OpVupd { static constexpr bool PRE = false; bf16* V; const bf16* VF; const float* v0p;
    __device__ __forceinline__ void operator()(int row, int pn, int ct, f32x4 v0, f32x4 v1) const {
        const int col = pn * 256 + ct; const size_t off = (size_t)row * D + col;
        const f32x4 g0 = sigm4(v0 + *(const f32x4*)(v0p + col)), g1 = sigm4(v1 + *(const f32x4*)(v0p + col + 4));
        f32x4 a, b, fa, fb; ld8(V + off, a, b); ld8(VF + off, fa, fb);
        st8(V + off, a + (fa - a) * g0, b + (fb - b) * g1); } };
struct Bias8 { f32x4 a, b; };
struct OpE { static constexpr bool PRE = true; typedef Bias8 PreT; bf16* E; const float* w0;
    __device__ __forceinline__ Bias8 pre(int, int pn, int ct) const { const int col = pn * 256 + ct; Bias8 p; p.a = *(const f32x4*)(w0 + col); p.b = *(const f32x4*)(w0 + col + 4); return p; }
    __device__ __forceinline__ void post(int row, int pn, int ct, f32x4 v0, f32x4 v1, Bias8 p) const {
        st8(E + (size_t)row * D + pn * 256 + ct, sigm4(v0 + p.a) * 0.6065306597f, sigm4(v1 + p.b) * 0.6065306597f); } };
struct OpA { static constexpr bool PRE = true; typedef Bias8 PreT; bf16* A; const float* a0;
    __device__ __forceinline__ Bias8 pre(int, int pn, int ct) const { const int col = pn * 256 + ct; Bias8 p; p.a = *(const f32x4*)(a0 + col); p.b = *(const f32x4*)(a0 + col + 4); return p; }
    __device__ __forceinline__ void post(int row, int pn, int ct, f32x4 v0, f32x4 v1, Bias8 p) const {
        st8(A + (size_t)row * D + pn * 256 + ct, sigm4(v0 + p.a), sigm4(v1 + p.b)); } };
struct OpG { static constexpr bool PRE = true; typedef u32x4 PreT; bf16* O; const bf16* PREB;
    __device__ __forceinline__ u32x4 pre(int row, int pn, int ct) const { return *(const u32x4*)(PREB + (size_t)row * D + pn * 256 + ct); }
    __device__ __forceinline__ void post(int row, int pn, int ct, f32x4 v0, f32x4 v1, u32x4 p) const { f32x4 a, b; unpk8(p, a, b); st8(O + (size_t)row * D + pn * 256 + ct, a * v0, b * v1); } };

template <class Op, bool ALIGN>
__device__ __forceinline__ void run_gemm(const int wv, LAS unsigned char* lds, const bf16* A, const bf16* Bt, int M, int N, int K, const Op& op, int row_off = 0, long long amap = 0, int apan = 0) {
    pg8::Gemm g{A, Bt, M, N, K}; pg8::StaticOrder S; S.init(M, N, (int)pg8::ogrid(), (int)pg8::obid()); S.amap = amap; S.apan = apan;
    Epi8<Op> E{op, row_off};
    pg8::gemm_phase<Epi8<Op>, pg8::StaticOrder, ALIGN, true>(lds, g, S, E, wv);
}

__device__ __forceinline__ void tr_item(const float* W, int K, int N, bf16* WT, int ldk, int row_off, LAS float* scr, int item, int lane) {
    const int nblk = N / 32, kb = item / nblk, nb = item % nblk, k0 = 64 * kb, n0 = 32 * nb;
#pragma unroll
    for (int i = 0; i < 32; ++i) { const int kk = 2 * i + (lane >> 5), kg = k0 + kk; scr[kk * 33 + (lane & 31)] = kg < K ? W[(size_t)kg * N + n0 + (lane & 31)] : 0.f; }
    asm volatile("s_waitcnt lgkmcnt(0)" ::: "memory");
    const int c = lane & 7;
#pragma unroll
    for (int j = 0; j < 4; ++j) { const int n = (lane >> 3) + 8 * j; const LAS float* s = scr + (8 * c) * 33 + n;
        u32x4 o; o.x = pk2(s[0 * 33], s[1 * 33]); o.y = pk2(s[2 * 33], s[3 * 33]); o.z = pk2(s[4 * 33], s[5 * 33]); o.w = pk2(s[6 * 33], s[7 * 33]);
        *(u32x4*)(WT + (size_t)(row_off + n0 + n) * ldk + k0 + 8 * c) = o; }
    asm volatile("s_waitcnt lgkmcnt(0)" ::: "memory");
}
#define CV_ITEM(Wp_, K_, N_, Kpad_, WTp_, roff_) { const int ni_ = ((Kpad_) / 64) * ((N_) / 32); if (r < ni_) { tr_item((Wp_), (K_), (N_), (WTp_), (Kpad_), (roff_), scr, r, lane); continue; } r -= ni_; }
__device__ __forceinline__ void conv_layer(const int wv, int layer, LAS unsigned char* lds) {
    const int tid = pg8::otid(wv), lane = tid & 63, wave = tid >> 6;
    const int gw = pg8::obid() * 8 + wave, ngw = pg8::ogrid() * 8;
    LAS float* scr = (LAS float*)(lds + wave * 16384);
    const int j = layer >> 1;
    const bool gm = (layer & 1) == 0;
    if (gm) {
        const float* ws = argp(10) + (size_t)j * 8 * 128 * 128; bf16* wsc = (bf16*)(WSB(WS_W) + W_WSC);
        for (int i = pg8::obid() * 512 + tid; i < 8 * 128 * 128 / 2; i += pg8::ogrid() * 512) {
            const int e = 2 * i, t = (e >> 7) & 127, s = e & 127; const f32x2 v = *(const f32x2*)(ws + e);
            *(unsigned*)(wsc + e) = pk2(s <= t ? v.x : 0.f, (s + 1) <= t ? v.y : 0.f); }
    }
    const int total = 2 * 2048 + (gm ? 1024 + 512 : 3 * 512 + 32 + 32 + 80 + 512 + 64 + 64 + 128 + (j > 0 ? 16 + 64 : 0));
    for (int it = gw; it < total; it += ngw) {
        int r = it;
        CV_ITEM(argp(5) + (size_t)layer * D * FF, D, FF, D, (bf16*)(WSB(WS_W) + W_W1), 0)
        CV_ITEM(argp(6) + (size_t)layer * FF * D, FF, D, FF, (bf16*)(WSB(WS_W) + W_W2), 0)
        if (gm) {
            CV_ITEM(argp(7) + (size_t)j * D * 2048, D, 2048, D, (bf16*)(WSB(WS_W) + W_WIN), 0)
            CV_ITEM(argp(12) + (size_t)j * D * D, D, D, D, (bf16*)(WSB(WS_W) + W_WOUT), 0)
        } else {
            CV_ITEM(argp(14) + (size_t)j * 3 * D * D, D, D, D, (bf16*)(WSB(WS_W) + W_STK), 0)
            CV_ITEM(argp(14) + (size_t)j * 3 * D * D + (size_t)D * D, D, D, D, (bf16*)(WSB(WS_W) + W_STK), 1024)
            CV_ITEM(argp(14) + (size_t)j * 3 * D * D + (size_t)2 * D * D, D, D, D, (bf16*)(WSB(WS_W) + W_STK), 2048)
            CV_ITEM(argp(16) + (size_t)j * D * 64, D, 64, D, (bf16*)(WSB(WS_W) + W_STK), 3072)
            CV_ITEM(argp(19) + (size_t)j * D * 64, D, 64, D, (bf16*)(WSB(WS_W) + W_STK), 3328)
            CV_ITEM(argp(21) + (size_t)j * D * 160, D, 160, D, (bf16*)(WSB(WS_W) + W_STK), 3584)
            CV_ITEM(argp(28) + (size_t)j * D * D, D, D, D, (bf16*)(WSB(WS_W) + W_WO), 0)
            CV_ITEM(argp(17) + (size_t)j * 64 * D, 64, D, 128, (bf16*)(WSB(WS_W) + W_LW2), 0)
            CV_ITEM(argp(20) + (size_t)j * 64 * D, 64, D, 128, (bf16*)(WSB(WS_W) + W_LA2), 0)
            CV_ITEM(argp(22) + (size_t)j * 160 * D, 160, D, 256, (bf16*)(WSB(WS_W) + W_LG2), 0)
            if (j > 0) {
                CV_ITEM(argp(30) + (size_t)(j - 1) * D * 32, D, 32, D, (bf16*)(WSB(WS_W) + W_STK), 3840)
                CV_ITEM(argp(31) + (size_t)(j - 1) * 32 * D, 32, D, 128, (bf16*)(WSB(WS_W) + W_LV2), 0)
            }
        }
    }
}
#undef CV_ITEM

__device__ __forceinline__ void ph_init_rows(const int wv, const float* x, float* H, bf16* HB) {
    const int tid = pg8::otid(wv), lane = tid & 63, gw = pg8::obid() * 8 + (tid >> 6), ngw = pg8::ogrid() * 8;
    for (int m0 = gw * 4; m0 < T; m0 += ngw * 4) {
        f32x4 v[4][4];
#pragma unroll
        for (int r = 0; r < 4; ++r)
#pragma unroll
            for (int jj = 0; jj < 4; ++jj) v[r][jj] = *(const f32x4*)(x + (size_t)(m0 + r) * D + 4 * lane + 256 * jj);
#pragma unroll
        for (int r = 0; r < 4; ++r)
#pragma unroll
            for (int jj = 0; jj < 4; ++jj) *(u32x2*)(HB + (size_t)(m0 + r) * D + 4 * lane + 256 * jj) = pk4(v[r][jj]);
    }
}
__device__ __forceinline__ void ph_ln(const int wv, float* H, bf16* HB, const float* g, const float* b, const bool src_h, const bool want_h, const bool want_hb) {
    const int tid = pg8::otid(wv), lane = tid & 63, gw = pg8::obid() * 8 + (tid >> 6), ngw = pg8::ogrid() * 8;
    f32x4 gv[4], bv[4];
#pragma unroll
    for (int jj = 0; jj < 4; ++jj) { gv[jj] = *(const f32x4*)(g + 4 * lane + 256 * jj); bv[jj] = *(const f32x4*)(b + 4 * lane + 256 * jj); }
    for (int m0 = gw; m0 < T; m0 += 2 * ngw) {
        const int m1 = m0 + ngw;
        float* hr0 = H + (size_t)m0 * D + 4 * lane; bf16* br0 = HB + (size_t)m0 * D + 4 * lane;
        float* hr1 = H + (size_t)(m1 < T ? m1 : m0) * D + 4 * lane; bf16* br1 = HB + (size_t)(m1 < T ? m1 : m0) * D + 4 * lane;
        f32x4 v[4], w[4];
        if (src_h) {
#pragma unroll
            for (int jj = 0; jj < 4; ++jj) { v[jj] = *(const f32x4*)(hr0 + 256 * jj); w[jj] = *(const f32x4*)(hr1 + 256 * jj); }
        } else {
#pragma unroll
            for (int jj = 0; jj < 4; ++jj) { v[jj] = unpk4(*(const u32x2*)(br0 + 256 * jj)); w[jj] = unpk4(*(const u32x2*)(br1 + 256 * jj)); }
        }
        float s0 = 0.f, s1 = 0.f;
#pragma unroll
        for (int jj = 0; jj < 4; ++jj) { s0 += sum4(v[jj]); s1 += sum4(w[jj]); }
        const float mean0 = wave_sum(s0) * (1.0f / D), mean1 = wave_sum(s1) * (1.0f / D); float q0 = 0.f, q1 = 0.f;
#pragma unroll
        for (int jj = 0; jj < 4; ++jj) { v[jj] = v[jj] - mean0; q0 += sum4(v[jj] * v[jj]); w[jj] = w[jj] - mean1; q1 += sum4(w[jj] * w[jj]); }
        const float rstd0 = 1.0f / sqrtf(wave_sum(q0) * (1.0f / D) + LN_EPS), rstd1 = 1.0f / sqrtf(wave_sum(q1) * (1.0f / D) + LN_EPS);
#pragma unroll
        for (int jj = 0; jj < 4; ++jj) { const f32x4 o = v[jj] * rstd0 * gv[jj] + bv[jj]; if (want_h) *(f32x4*)(hr0 + 256 * jj) = o; if (want_hb) *(u32x2*)(br0 + 256 * jj) = pk4(o); }
        if (m1 < T) {
#pragma unroll
            for (int jj = 0; jj < 4; ++jj) { const f32x4 o = w[jj] * rstd1 * gv[jj] + bv[jj]; if (want_h) *(f32x4*)(hr1 + 256 * jj) = o; if (want_hb) *(u32x2*)(br1 + 256 * jj) = pk4(o); }
        }
    }
}
__device__ __forceinline__ void ph_mixprep(const int wv, const bf16* HB, bf16* XMIX, const float* mu, int q) {
    constexpr int PR = T / 4;
    const int tid = pg8::otid(wv), lane = tid & 63, gw = pg8::obid() * 8 + (tid >> 6), ngw = pg8::ogrid() * 8;
    for (int lm0 = gw * 4; lm0 < PR; lm0 += ngw * 4) {
        const int m0 = q * PR + lm0; const bool first = (m0 % SEQ) == 0;
        u32x2 raw[5][4];
#pragma unroll
        for (int r = 0; r < 5; ++r)
#pragma unroll
            for (int jj = 0; jj < 4; ++jj) raw[r][jj] = (r == 0 && first) ? (u32x2){0u, 0u} : *(const u32x2*)(HB + (size_t)(m0 + r - 1) * D + 4 * lane + 256 * jj);
#pragma unroll
        for (int jj = 0; jj < 4; ++jj) { const int col = 4 * lane + 256 * jj;
            f32x4 mv[6];
#pragma unroll
            for (int i = 0; i < 6; ++i) mv[i] = *(const f32x4*)(mu + i * D + col);
#pragma unroll
            for (int r = 0; r < 4; ++r) { const f32x4 xp = unpk4(raw[r][jj]), x = unpk4(raw[r + 1][jj]); const f32x4 xx = xp - x;
#pragma unroll
                for (int i = 0; i < 6; ++i) *(u32x2*)(XMIX + ((size_t)i * PR + lm0 + r) * D + col) = pk4(x + xx * mv[i]); }
        }
    }
}
__device__ __forceinline__ void ph_post(const int wv, bf16* Y, const bf16* R, const bf16* K, const bf16* V, const bf16* A, const float* k_a, const float* r_k, const float* gn_g, const float* gn_b) {
    const int tid = pg8::otid(wv), lane = tid & 63, gw = pg8::obid() * 8 + (tid >> 6), ngw = pg8::ogrid() * 8;
    for (int m0 = gw * 2; m0 < T; m0 += ngw * 2) {
        u32x2 ry[2][4], rr[2][4], rk[2][4], rv[2][4], ra[2][4];
#pragma unroll
        for (int r = 0; r < 2; ++r)
#pragma unroll
            for (int jj = 0; jj < 4; ++jj) { const size_t off = (size_t)(m0 + r) * D + 4 * lane + 256 * jj;
                ry[r][jj] = *(const u32x2*)(Y + off); rr[r][jj] = *(const u32x2*)(R + off); rk[r][jj] = *(const u32x2*)(K + off); rv[r][jj] = *(const u32x2*)(V + off); ra[r][jj] = *(const u32x2*)(A + off); }
#pragma unroll
        for (int jj = 0; jj < 4; ++jj) { const int col = 4 * lane + 256 * jj;
            const f32x4 ka = *(const f32x4*)(k_a + col), rkk = *(const f32x4*)(r_k + col), gg = *(const f32x4*)(gn_g + col), gb = *(const f32x4*)(gn_b + col);
#pragma unroll
            for (int r = 0; r < 2; ++r) { const size_t off = (size_t)(m0 + r) * D + col;
                const f32x4 y = unpk4(ry[r][jj]), rq = unpk4(rr[r][jj]), k = unpk4(rk[r][jj]), v = unpk4(rv[r][jj]), a = unpk4(ra[r][jj]);
                const float mean = red16(sum4(y)) * (1.0f / 64.0f); const f32x4 d = y - mean;
                const float var = red16(sum4(d * d)) * (1.0f / 64.0f); const float rstd = 1.0f / sqrtf(var + GN_EPS);
                const f32x4 kp = k * ((a - 1.0f) * ka + 1.0f);
                const float s = red16(sum4(rq * kp * rkk));
                *(u32x2*)(Y + off) = pk4(d * rstd * gg + gb + v * s); }
        }
    }
}

__device__ __forceinline__ void ph_spatial(const int wv, LAS unsigned char* lds, const bf16* ZB, bf16* GB, const bf16* WSC, const float* vng, const float* vnb, const float* bs) {
    const int tid = pg8::otid(wv), lane = tid & 63, wave = tid >> 6, fr = lane & 15, fq = lane >> 4;
    LAS bf16* Wc = (LAS bf16*)lds; LAS bf16* vT = (LAS bf16*)(lds + 34816); LAS float* stats = (LAS float*)(lds + 69632);
    for (int ch = pg8::obid(); ch < T / 128; ch += pg8::ogrid()) {
        const size_t row0 = (size_t)ch * 128;
#pragma unroll 1
        for (int rb = 0; rb < 16; rb += 8) {
            u32x4 ra[8], rc[8];
#pragma unroll
            for (int rr = 0; rr < 8; ++rr) { const bf16* vp = ZB + (row0 + wave * 16 + rb + rr) * 2048 + 1024 + 8 * lane; ra[rr] = *(const u32x4*)vp; rc[rr] = *(const u32x4*)(vp + 512); }
#pragma unroll
            for (int rr = 0; rr < 8; ++rr) { const int s = wave * 16 + rb + rr;
                f32x4 a = (f32x4){bflo(ra[rr].x), bfhi(ra[rr].x), bflo(ra[rr].y), bfhi(ra[rr].y)}, b = (f32x4){bflo(ra[rr].z), bfhi(ra[rr].z), bflo(ra[rr].w), bfhi(ra[rr].w)};
                f32x4 c = (f32x4){bflo(rc[rr].x), bfhi(rc[rr].x), bflo(rc[rr].y), bfhi(rc[rr].y)}, d = (f32x4){bflo(rc[rr].z), bfhi(rc[rr].z), bflo(rc[rr].w), bfhi(rc[rr].w)};
                const float mean = wave_sum((sum4(a) + sum4(b)) + (sum4(c) + sum4(d))) * (1.0f / 1024.0f);
                a = a - mean; b = b - mean; c = c - mean; d = d - mean;
                const float var = wave_sum((sum4(a * a) + sum4(b * b)) + (sum4(c * c) + sum4(d * d))) * (1.0f / 1024.0f);
                if (lane == 0) { stats[2 * s] = mean; stats[2 * s + 1] = 1.0f / sqrtf(var + LN_EPS); } }
        }
        __syncthreads();
        u32x4 wR[4], vR[2][2]; f32x4 pg0[2], pg1[2], po0[2], po1[2];
#define SP_LOAD(g_) do { _Pragma("unroll") for (int i = 0; i < 4; ++i) { const int p = tid + 512 * i, row = p >> 4, c8 = (p & 15) * 8; wR[i] = *(const u32x4*)(WSC + (g_) * 16384 + row * 128 + c8); } \
            _Pragma("unroll") for (int q = 0; q < 2; ++q) { const int col = (g_) * 128 + (wave * 2 + q) * 8; \
                vR[q][0] = *(const u32x4*)(ZB + (row0 + 2 * lane) * 2048 + 1024 + col); vR[q][1] = *(const u32x4*)(ZB + (row0 + 2 * lane + 1) * 2048 + 1024 + col); \
                pg0[q] = *(const f32x4*)(vng + col); pg1[q] = *(const f32x4*)(vng + col + 4); po0[q] = *(const f32x4*)(vnb + col); po1[q] = *(const f32x4*)(vnb + col + 4); } } while (0)
        SP_LOAD(0);
        const int tb = wave >> 1, db = wave & 1;
        for (int g = 0; g < 8; ++g) {
#pragma unroll
            for (int i = 0; i < 4; ++i) { const int p = tid + 512 * i, row = p >> 4, c8 = (p & 15) * 8; *(LAS u32x4*)(Wc + row * 136 + c8) = wR[i]; }
            { const int s = 2 * lane; const f32x4 sv = *(const LAS f32x4*)(stats + 2 * s);
#pragma unroll
              for (int q = 0; q < 2; ++q) { const int d8 = (wave * 2 + q) * 8;
                  f32x4 a0 = (f32x4){bflo(vR[q][0].x), bfhi(vR[q][0].x), bflo(vR[q][0].y), bfhi(vR[q][0].y)}, a1 = (f32x4){bflo(vR[q][0].z), bfhi(vR[q][0].z), bflo(vR[q][0].w), bfhi(vR[q][0].w)};
                  f32x4 b0 = (f32x4){bflo(vR[q][1].x), bfhi(vR[q][1].x), bflo(vR[q][1].y), bfhi(vR[q][1].y)}, b1 = (f32x4){bflo(vR[q][1].z), bfhi(vR[q][1].z), bflo(vR[q][1].w), bfhi(vR[q][1].w)};
                  a0 = (a0 - sv.x) * sv.y * pg0[q] + po0[q]; a1 = (a1 - sv.x) * sv.y * pg1[q] + po1[q]; b0 = (b0 - sv.z) * sv.w * pg0[q] + po0[q]; b1 = (b1 - sv.z) * sv.w * pg1[q] + po1[q];
                  LAS bf16* dst = vT + d8 * 136 + s;
                  *(LAS unsigned*)(dst + 0 * 136) = pk2(a0.x, b0.x); *(LAS unsigned*)(dst + 1 * 136) = pk2(a0.y, b0.y); *(LAS unsigned*)(dst + 2 * 136) = pk2(a0.z, b0.z); *(LAS unsigned*)(dst + 3 * 136) = pk2(a0.w, b0.w);
                  *(LAS unsigned*)(dst + 4 * 136) = pk2(a1.x, b1.x); *(LAS unsigned*)(dst + 5 * 136) = pk2(a1.y, b1.y); *(LAS unsigned*)(dst + 6 * 136) = pk2(a1.z, b1.z); *(LAS unsigned*)(dst + 7 * 136) = pk2(a1.w, b1.w); } }
            __syncthreads();
            u32x2 uR[2][4];
#pragma unroll
            for (int mm = 0; mm < 2; ++mm)
#pragma unroll
                for (int n = 0; n < 4; ++n) uR[mm][n] = *(const u32x2*)(ZB + (row0 + 32 * tb + 16 * mm + fr) * 2048 + g * 128 + 64 * db + 16 * n + 4 * fq);
            if (g + 1 < 8) SP_LOAD(g + 1);
            f32x4 acc[2][4];
#pragma unroll
            for (int mm = 0; mm < 2; ++mm)
#pragma unroll
                for (int n = 0; n < 4; ++n) acc[mm][n] = (f32x4){0.f, 0.f, 0.f, 0.f};
            for (int kk = 0; kk <= tb; ++kk) {
                bf16x8 Af[2], Xf[4];
#pragma unroll
                for (int mm = 0; mm < 2; ++mm) Af[mm] = *(const LAS bf16x8*)(Wc + (32 * tb + 16 * mm + fr) * 136 + 32 * kk + 8 * fq);
#pragma unroll
                for (int n = 0; n < 4; ++n) Xf[n] = *(const LAS bf16x8*)(vT + (64 * db + 16 * n + fr) * 136 + 32 * kk + 8 * fq);
#pragma unroll
                for (int mm = 0; mm < 2; ++mm)
#pragma unroll
                    for (int n = 0; n < 4; ++n) acc[mm][n] = __builtin_amdgcn_mfma_f32_16x16x32_bf16(Xf[n], Af[mm], acc[mm][n], 0, 0, 0);
            }
#pragma unroll
            for (int mm = 0; mm < 2; ++mm) { const int t = 32 * tb + 16 * mm + fr; const float bsv = bs[g * 128 + t];
#pragma unroll
                for (int n = 0; n < 4; ++n) { const int col = g * 128 + 64 * db + 16 * n + 4 * fq;
                    *(u32x2*)(GB + (row0 + t) * D + col) = pk4(unpk4(uR[mm][n]) * (acc[mm][n] + bsv)); } }
            __syncthreads();
        }
#undef SP_LOAD
    }
}

constexpr int SC_P64 = 72, SC_P32 = 40;
constexpr int SC_BKT = 0, SC_ART = 4608, SC_AJT = 9216, SC_BKH = 14336, SC_UV = 19456, SC_AHT = 22016, SC_INVT = 24320, SC_MB = 25600, SC_MITP = 26880, SC_PQT = 28160, SC_NF = SC_AHT  , SC_GC = 29440, SC_CH = 29696;
constexpr int SC_SB = 4 * SC_CH, SC_YB = SC_SB + 2 * 4608, SC_END = SC_YB + 8192;
static_assert(SC_END <= LDS_BYTES - 16, "scan LDS map");
__device__ __forceinline__ bf16x8 sc_frag(const LAS unsigned char* base, int pitch, int row, int k) { return *(const LAS bf16x8*)(base + (row * pitch + k) * 2); }
__device__ __forceinline__ void sc_st(LAS unsigned char* base, int idx, float v) { *(LAS __bf16*)(base + idx * 2) = (__bf16)v; }
__device__ __forceinline__ void sc_stf(LAS unsigned char* base, int idx, float v) { *(LAS unsigned short*)(base + idx * 2) = (unsigned short)pk2(v, v); }
__device__ __forceinline__ float sc_ld(const bf16* p) { return __uint_as_float((unsigned)(*p) << 16); }
constexpr int SC_SBP = 4 * SC_CH, SC_YB2 = SC_SBP + 2 * 2304, SC_END2 = SC_YB2 + 2 * 2048, SC_RAW = SC_END2, SC_ESUM = SC_RAW + 4 * 2 * 2560;
static_assert(SC_ESUM + 2048 <= LDS_BYTES - 16, "scan LDS map");
struct ScanCtx { const bf16 *R, *K, *V, *A, *E; bf16* Y; size_t tok0; int h, half, col, p4, hb; unsigned lane2, dmaoff; float kkc, kac; };
__device__ __forceinline__ float sc_ldl(const bf16* rowp, unsigned off2) { return __uint_as_float((unsigned)(*(const bf16*)((const char*)rowp + off2)) << 16); }
#define SC_DMA1(n_, sl_) do { const int nn_ = (n_) < SEQ / 16 ? (n_) : SEQ / 16 - 1; const size_t rb_ = (cx.tok0 + (size_t)nn_ * 16) * D + cx.hb; LAS unsigned char* rw_ = lds + SC_RAW + (wv - 2) * 5120 + (sl_) * 2560; \
            _Pragma("unroll") for (int sp = 0; sp < 2; ++sp) { const size_t ro_ = rb_ + (size_t)(cx.p4 + 2 * sp) * D; \
                __builtin_amdgcn_global_load_lds((const unsigned*)((const char*)(cx.E + ro_) + cx.dmaoff), (LAS unsigned*)(rw_ + (0 + sp) * 256), 4, 0, 0); \
                __builtin_amdgcn_global_load_lds((const unsigned*)((const char*)(cx.R + ro_) + cx.dmaoff), (LAS unsigned*)(rw_ + (2 + sp) * 256), 4, 0, 0); \
                __builtin_amdgcn_global_load_lds((const unsigned*)((const char*)(cx.K + ro_) + cx.dmaoff), (LAS unsigned*)(rw_ + (4 + sp) * 256), 4, 0, 0); \
                __builtin_amdgcn_global_load_lds((const unsigned*)((const char*)(cx.V + ro_) + cx.dmaoff), (LAS unsigned*)(rw_ + (6 + sp) * 256), 4, 0, 0); \
                __builtin_amdgcn_global_load_lds((const unsigned*)((const char*)(cx.A + ro_) + cx.dmaoff), (LAS unsigned*)(rw_ + (8 + sp) * 256), 4, 0, 0); } } while (0)
#define SC_ESUM1(m_) do { const LAS unsigned char* re_ = lds + SC_RAW + (wv - 2) * 5120 + ((m_) & 1) * 2560 + 2 * lane; \
            const float es_ = (SC_F((unsigned)*(const LAS unsigned short*)(re_)) + SC_F((unsigned)*(const LAS unsigned short*)(re_ + 128))) + (SC_F((unsigned)*(const LAS unsigned short*)(re_ + 256)) + SC_F((unsigned)*(const LAS unsigned short*)(re_ + 384))); \
            *(LAS float*)(lds + SC_ESUM + (((m_) & 1) * 4 + (wv - 2)) * 256 + 4 * lane) = es_; } while (0)
#define SC_RAWU(slot_, s_) ((unsigned)*(const LAS unsigned short*)(rw + ((slot_) + ((s_) >> 1)) * 256 + ((s_) & 1) * 128 + 2 * lane))
#define SC_F(u_) __uint_as_float((u_) << 16)
__device__ __forceinline__ void sc_tick(const int k, const int wv, LAS unsigned char* lds, const ScanCtx& cx, const f32x4 zero4, f32x4& St0, f32x4& St1, f32x4& St2, f32x4& St3, float (&X)[16]) {
    constexpr int NCH = SEQ / 16;
    const bf16* R = cx.R; const bf16* K = cx.K; const bf16* V = cx.V; const bf16* A = cx.A; const bf16* E = cx.E; bf16* Y = cx.Y;
    const size_t tok0 = cx.tok0; const int h = cx.h, half = cx.half, p4 = cx.p4; const float kkc = cx.kkc, kac = cx.kac;
    (void)R; (void)K; (void)V; (void)A; (void)E;
            const int lane = pg8::olane(), fr = lane & 15, fq = lane >> 4;
            if (wv < 2) {
                if (k >= 0 && k < NCH) {
                    LAS unsigned char* cb = lds + (k & 3) * SC_CH; LAS unsigned char* sbp = lds + SC_SBP + wv * 2304; const int r0 = 16 * wv;
                    const f32x4 Wt = __builtin_amdgcn_mfma_f32_16x16x32_bf16(sc_frag(cb + SC_UV, SC_P32, r0 + fr, 8 * fq), sc_frag(cb + SC_MITP, SC_P32, fr, 8 * fq), zero4, 0, 0, 0);
                    const bf16x8 x0 = sc_frag(sbp, SC_P64, fr, 8 * fq), x1 = sc_frag(sbp, SC_P64, fr, 32 + 8 * fq);
                    f32x4 u = __builtin_amdgcn_mfma_f32_16x16x32_bf16(x0, sc_frag(cb + SC_AHT, SC_P64, fr, 8 * fq), Wt, 0, 0, 0);
                    u = __builtin_amdgcn_mfma_f32_16x16x32_bf16(x1, sc_frag(cb + SC_AHT, SC_P64, fr, 32 + 8 * fq), u, 0, 0, 0);
#pragma unroll
                    for (int i = 0; i < 4; ++i) sc_st(cb + SC_UV, (r0 + 4 * fq + i) * SC_P32 + fr, u[i]);
                    f32x4 ya = __builtin_amdgcn_mfma_f32_16x16x32_bf16(x0, sc_frag(cb + SC_ART, SC_P64, 16 + fr, 8 * fq), zero4, 0, 0, 0);
                    ya = __builtin_amdgcn_mfma_f32_16x16x32_bf16(x1, sc_frag(cb + SC_ART, SC_P64, 16 + fr, 32 + 8 * fq), ya, 0, 0, 0);
                    asm volatile("s_waitcnt lgkmcnt(0)" ::: "memory");
                    const bf16x8 uv = sc_frag(cb + SC_UV, SC_P32, r0 + fr, 8 * fq);
                    ya = __builtin_amdgcn_mfma_f32_16x16x32_bf16(uv, sc_frag(cb + SC_PQT, SC_P32, fr, 8 * fq), ya, 0, 0, 0);
                    LAS float* yb = (LAS float*)(lds + SC_YB2 + (k & 1) * 2048);
#pragma unroll
                    for (int i = 0; i < 4; ++i) yb[fr * 32 + r0 + 4 * fq + i] = ya[i];
                    const LAS float* gcp = (const LAS float*)(cb + SC_GC);
                          St0 = __builtin_amdgcn_mfma_f32_16x16x32_bf16(uv, sc_frag(cb + SC_BKH, SC_P32, fr, 8 * fq), St0, 0, 0, 0); St0 = St0 * gcp[fr];
                     St1 = __builtin_amdgcn_mfma_f32_16x16x32_bf16(uv, sc_frag(cb + SC_BKH, SC_P32, 16 + fr, 8 * fq), St1, 0, 0, 0); St1 = St1 * gcp[16 + fr];
                     St2 = __builtin_amdgcn_mfma_f32_16x16x32_bf16(uv, sc_frag(cb + SC_BKH, SC_P32, 32 + fr, 8 * fq), St2, 0, 0, 0); St2 = St2 * gcp[32 + fr];
                     St3 = __builtin_amdgcn_mfma_f32_16x16x32_bf16(uv, sc_frag(cb + SC_BKH, SC_P32, 48 + fr, 8 * fq), St3, 0, 0, 0); St3 = St3 * gcp[48 + fr];
#pragma unroll
                    for (int i = 0; i < 4; ++i) { sc_st(sbp, (4 * fq + i) * SC_P64 + fr, St0[i]); sc_st(sbp, (4 * fq + i) * SC_P64 + 16 + fr, St1[i]); sc_st(sbp, (4 * fq + i) * SC_P64 + 32 + fr, St2[i]); sc_st(sbp, (4 * fq + i) * SC_P64 + 48 + fr, St3[i]); }
                    asm volatile("s_waitcnt lgkmcnt(0)" ::: "memory");
                }
            } else if (wv < 6) {
                const int n = k + 3;
                const LAS unsigned char* rw = lds + SC_RAW + (wv - 2) * 5120 + (n & 1) * 2560;
                unsigned pem[4], pr[4], pk[4], pv[4], pa[4];
#pragma unroll
                for (int s = 0; s < 4; ++s) { pem[s] = SC_RAWU(0, s); pr[s] = SC_RAWU(2, s); pk[s] = SC_RAWU(4, s); pv[s] = SC_RAWU(6, s); pa[s] = SC_RAWU(8, s); }
                float cum = 0.f;
#pragma unroll
                for (int q = 0; q < 3; ++q) { const float t_ = *(const LAS float*)(lds + SC_ESUM + ((n & 1) * 4 + q) * 256 + 4 * lane); cum += (4 * q < p4) ? t_ : 0.f; }
                asm volatile("s_waitcnt lgkmcnt(0)" ::: "memory");
                SC_DMA1(n + 2, n & 1);
                if (n < NCH) {
                    LAS unsigned char* cb = lds + (n & 3) * SC_CH;
                    float at4[4], nbh4[4], kh4[4];
#pragma unroll
                    for (int s = 0; s < 4; ++s) {
                        const int t = p4 + s; const float e = SC_F(pem[s]), pks = SC_F(pk[s]), pas = SC_F(pa[s]), prs = SC_F(pr[s]);
                        const float kkr = pks * kkc; const float n2 = wave_sum(kkr * kkr); const float kk = kkr * __builtin_amdgcn_rsqf(fmaxf(n2, 1e-24f));
                        const float kp = pks * ((pas - 1.0f) * kac + 1.0f), bb = kk * pas;
                        const float gprev = __expf(-cum); cum += e; const float gg = __expf(-cum), ginv = __builtin_amdgcn_rcpf(gg);
                        const float At = kk * gprev;
                        sc_stf(cb + SC_BKT, t * SC_P64 + lane, bb * ginv); sc_stf(cb + SC_BKT, (16 + t) * SC_P64 + lane, kp * ginv);
                        sc_stf(cb + SC_ART, t * SC_P64 + lane, At);        sc_stf(cb + SC_ART, (16 + t) * SC_P64 + lane, prs * gg);
                        at4[s] = At; nbh4[s] = -(bb * ginv); kh4[s] = kp * ginv;
                    }
                    u32x2 w2;
                    w2.x = pk2(at4[0], at4[1]); w2.y = pk2(at4[2], at4[3]);     *(LAS u32x2*)(cb + SC_AJT + (lane * SC_P32 + p4) * 2) = w2;
                    w2.x = pk2(nbh4[0], nbh4[1]); w2.y = pk2(nbh4[2], nbh4[3]); *(LAS u32x2*)(cb + SC_BKH + (lane * SC_P32 + p4) * 2) = w2;
                    w2.x = pk2(kh4[0], kh4[1]); w2.y = pk2(kh4[2], kh4[3]);     *(LAS u32x2*)(cb + SC_BKH + (lane * SC_P32 + 16 + p4) * 2) = w2;
                    if ((lane >> 5) == half) { w2.x = pv[0] | (pv[1] << 16); w2.y = pv[2] | (pv[3] << 16); *(LAS u32x2*)(cb + SC_UV + ((lane & 31) * SC_P32 + 16 + p4) * 2) = w2; }
                    if (p4 == 12) *(LAS float*)(cb + SC_GC + lane * 4) = __expf(-cum);
                }
                asm volatile("s_waitcnt vmcnt(10)" ::: "memory");
                SC_ESUM1(n + 1);
            } else if ((wv - 6) == (k & 1)) {
                const int n = k + 2;
                if (n >= 0 && n < NCH) {
                    LAS unsigned char* cb = lds + (n & 3) * SC_CH;
#pragma unroll
                    for (int q = 0; q < 4; ++q) { const int mt2 = q >> 1, nt2 = q & 1;
                        f32x4 acc = zero4;
#pragma unroll
                        for (int ks = 0; ks < 2; ++ks) acc = __builtin_amdgcn_mfma_f32_16x16x32_bf16(sc_frag(cb + SC_BKT, SC_P64, 16 * mt2 + fr, 32 * ks + 8 * fq), sc_frag(cb + SC_ART, SC_P64, 16 * nt2 + fr, 32 * ks + 8 * fq), acc, 0, 0, 0);
#pragma unroll
                        for (int i = 0; i < 4; ++i) { const int s = 4 * fq + i, t = fr; const float val = acc[i];
                            if (q == 0) *(LAS float*)(cb + SC_NF + (s * 16 + t) * 4) = s < t ? val : 0.f;
                            else if (q == 2) sc_st(cb + SC_MB, s * SC_P32 + t, s < t ? val : 0.f);
                            else if (q == 1) sc_st(cb + SC_PQT, t * SC_P32 + s, s <= t ? -val : 0.f);
                            else sc_st(cb + SC_PQT, t * SC_P32 + 16 + s, s <= t ? val : 0.f); } }
                    asm volatile("s_waitcnt lgkmcnt(0)" ::: "memory");
                    const LAS float* Nf = (const LAS float*)(cb + SC_NF);
                    X[15] = (fr == 15) ? 1.f : 0.f;
                    {   f32x4 Nq[12]; int idx = 0;
#pragma unroll
                        for (int s = 7; s < 15; ++s)
#pragma unroll
                            for (int q = (s + 1) / 4; q < 4; ++q) Nq[idx++] = *(const LAS f32x4*)(Nf + s * 16 + 4 * q);
                        __builtin_amdgcn_sched_barrier(0);
                        int base = 12;
#pragma unroll
                        for (int s = 14; s >= 7; --s) { const int q0 = (s + 1) / 4; base -= 4 - q0; float a = (s == fr) ? 1.f : 0.f;
#pragma unroll
                            for (int t = s + 1; t < 16; ++t) a -= Nq[base + t / 4 - q0][t & 3] * X[t];
                            X[s] = a; }
                    }
                }
                if (k >= 1 && k <= NCH) {
                    const LAS float* yb = (const LAS float*)(lds + SC_YB2 + ((k - 1) & 1) * 2048) + (lane >> 2) * 32 + 8 * (lane & 3);
                    const f32x4 y0 = *(const LAS f32x4*)yb, y1 = *(const LAS f32x4*)(yb + 4);
                    st8(Y + (tok0 + (size_t)(k - 1) * 16 + (lane >> 2)) * D + h * 64 + half * 32 + 8 * (lane & 3), y0, y1);
                }
            } else {
                const int n = k + 1;
                if (n >= 0 && n < NCH) {
                    LAS unsigned char* cb = lds + (n & 3) * SC_CH; const LAS float* Nf = (const LAS float*)(cb + SC_NF);
                    {   f32x4 Nq[24]; int idx = 0;
#pragma unroll
                        for (int s = 0; s < 7; ++s)
#pragma unroll
                            for (int q = (s + 1) / 4; q < 4; ++q) Nq[idx++] = *(const LAS f32x4*)(Nf + s * 16 + 4 * q);
                        __builtin_amdgcn_sched_barrier(0);
                        int base = 24;
#pragma unroll
                        for (int s = 6; s >= 0; --s) { const int q0 = (s + 1) / 4; base -= 4 - q0; float a = (s == fr) ? 1.f : 0.f;
#pragma unroll
                            for (int t = s + 1; t < 16; ++t) a -= Nq[base + t / 4 - q0][t & 3] * X[t];
                            X[s] = a; }
                    }
                    if (fq == 0) {
#pragma unroll
                        for (int s = 0; s < 16; s += 2) *(LAS unsigned*)(cb + SC_INVT + (fr * SC_P32 + s) * 2) = pk2(X[s], X[s + 1]); }
                    asm volatile("s_waitcnt lgkmcnt(0)" ::: "memory");
                    const bf16x8 iv = sc_frag(cb + SC_INVT, SC_P32, fr, 8 * fq);
#pragma unroll
                    for (int sub = 0; sub < 4; ++sub) { const f32x4 acc = __builtin_amdgcn_mfma_f32_16x16x32_bf16(iv, sc_frag(cb + SC_AJT, SC_P32, 16 * sub + fr, 8 * fq), zero4, 0, 0, 0);
#pragma unroll
                        for (int i = 0; i < 4; ++i) sc_st(cb + SC_AHT, (4 * fq + i) * SC_P64 + 16 * sub + fr, acc[i]); }
                    { const f32x4 acc = __builtin_amdgcn_mfma_f32_16x16x32_bf16(sc_frag(cb + SC_MB, SC_P32, fr, 8 * fq), iv, zero4, 0, 0, 0);
#pragma unroll
                      for (int i = 0; i < 4; ++i) sc_st(cb + SC_MITP, fr * SC_P32 + 16 + 4 * fq + i, acc[i]); }
                }
            }
}
__device__ __forceinline__ void ph_scan(const int wv, LAS unsigned char* lds, const bf16* R, const bf16* K, const bf16* V, const bf16* A, const bf16* E, bf16* Y, const float* k_k, const float* k_a) {
    const int lane = pg8::olane();
    float zf = 0.f; asm volatile("" : "+v"(zf));
    const f32x4 zero4 = (f32x4){zf, zf, zf, zf};
    constexpr int NCH = SEQ / 16;
    for (int unit = pg8::obid(); unit < NB * 32; unit += pg8::ogrid()) {
        ScanCtx cx; cx.R = R; cx.K = K; cx.V = V; cx.A = A; cx.E = E; cx.Y = Y;
        cx.h = (unit >> 1) & 15; cx.half = unit & 1; cx.tok0 = (size_t)(unit >> 5) * SEQ; cx.col = cx.h * 64 + lane; cx.p4 = 4 * (wv - 2); cx.hb = cx.h * 64; cx.lane2 = 2u * (unsigned)lane; cx.dmaoff = (unsigned)((lane >> 5) * D * 2 + (lane & 31) * 4);
        cx.kkc = k_k[cx.col]; cx.kac = k_a[cx.col];
        for (int i = (wv << 6) + lane; i < SC_END2 / 16; i += 512) ((LAS f32x4*)lds)[i] = zero4;
        __syncthreads();
        f32x4 St0 = zero4, St1 = zero4, St2 = zero4, St3 = zero4;
        float Xs[16];
#pragma unroll
        for (int i = 0; i < 16; ++i) Xs[i] = zf;
        if (wv >= 2 && wv < 6) { SC_DMA1(0, 0); SC_DMA1(1, 1); asm volatile("s_waitcnt vmcnt(10)" ::: "memory"); SC_ESUM1(0); }
        __syncthreads();
        for (int k = -3; k < NCH + 1; k += 2) {
            sc_tick(k, wv, lds, cx, zero4, St0, St1, St2, St3, Xs);
            __syncthreads();
            sc_tick(k + 1, wv, lds, cx, zero4, St0, St1, St2, St3, Xs);
            __syncthreads();
        }
        asm volatile("s_waitcnt vmcnt(0)" ::: "memory");
        __syncthreads();
    }
}
#undef SC_DMA1
#undef SC_ESUM1
#undef SC_RAWU
#undef SC_F

#define XB_TMO      128
#define XB_XCNT(j)  (256  + 64 * (j))
#define XB_XSUB(j)  (1280 + 64 * (j))
#define XB_XGEN(j)  (2304 + 64 * (j))
#define XB_TOP      3328
#define XB_TOPGEN   3392
#define XCD_BAR_WORDS 3456
#define XB_SPIN_CAP (1u << 18)

__device__ __forceinline__ unsigned xb_ld(unsigned* p)              { return __hip_atomic_load(p, __ATOMIC_RELAXED, __HIP_MEMORY_SCOPE_AGENT); }
__device__ __forceinline__ unsigned xb_add(unsigned* p, unsigned v) { return __hip_atomic_fetch_add(p, v, __ATOMIC_RELAXED, __HIP_MEMORY_SCOPE_AGENT); }
__device__ __forceinline__ unsigned xb_xcc_id() { return (unsigned)__builtin_amdgcn_s_getreg((3 << 11) | 20) & 0xFu; }
#define XB_SPIN(cond, bar) do { unsigned _sp = 0; while (cond) { __builtin_amdgcn_s_sleep(1); \
    if ((++_sp & 255u) == 0u) { if (xb_ld(&(bar)[XB_TMO])) break; if (_sp > XB_SPIN_CAP) { atomicAdd(&(bar)[XB_TMO], 1u); break; } } } } while (0)

struct XcdBarrier {
    unsigned* bar; unsigned x;
    volatile LAS unsigned* st;
};

__device__ __forceinline__ XcdBarrier xcd_barrier_post(unsigned* bar, volatile LAS unsigned* st, const bool t0) {
    XcdBarrier b; b.bar = bar; b.x = xb_xcc_id(); b.st = st;
    if (t0) (void)xb_add(&bar[XB_XCNT(b.x)], 1u);
    return b;
}
__device__ __forceinline__ void xcd_barrier_complete(unsigned* bar, unsigned x, unsigned& nloc, unsigned& nx) {
    const unsigned G = gridDim.x * gridDim.y * gridDim.z;
    unsigned sum, cnt, mine, sp = 0u;
    for (;;) {
        sum = 0u; cnt = 0u; mine = 0u;
#pragma unroll
        for (unsigned j = 0; j < 16; ++j) { const unsigned c = xb_ld(&bar[XB_XCNT(j)]); sum += c; cnt += (c > 0u) ? 1u : 0u; mine = (j == x) ? c : mine; }
        if (sum == G) break;
        __builtin_amdgcn_s_sleep(1);
        if ((++sp & 255u) == 0u) { if (xb_ld(&bar[XB_TMO])) break; if (sp > XB_SPIN_CAP) { atomicAdd(&bar[XB_TMO], 1u); break; } }
    }
    nloc = mine > 0u ? mine : 1u; nx = cnt > 0u ? cnt : 1u;
}

__device__ __forceinline__ void xcd_barrier(const XcdBarrier& b, const bool t0) {
    asm volatile("s_waitcnt vmcnt(0)" ::: "memory");
    __syncthreads();
    if (t0) {
        unsigned* bar = b.bar;
        __builtin_amdgcn_s_waitcnt(0);
        unsigned nloc = b.st[0], nx = b.st[1];
        if (nloc == 0u) { xcd_barrier_complete(bar, b.x, nloc, nx); b.st[0] = nloc; b.st[1] = nx; }
        const unsigned old = xb_add(&bar[XB_XSUB(b.x)], 1u);
        const unsigned gen = old / nloc;
        if (old + 1u == (gen + 1u) * nloc) {
            __builtin_amdgcn_fence(__ATOMIC_RELEASE, "agent");
            asm volatile("s_waitcnt vmcnt(0)" ::: "memory");
            const unsigned og = xb_add(&bar[XB_TOP], 1u);
            const unsigned tg = og / nx;
            if (og + 1u == (tg + 1u) * nx) xb_add(&bar[XB_TOPGEN], 1u);
            else XB_SPIN(xb_ld(&bar[XB_TOPGEN]) == tg, bar);
            __builtin_amdgcn_fence(__ATOMIC_ACQUIRE, "agent");
            xb_add(&bar[XB_XGEN(b.x)], 1u);
            asm volatile("s_waitcnt vmcnt(0)" ::: "memory");
        } else {
            XB_SPIN(xb_ld(&bar[XB_XGEN(b.x)]) == gen, bar);
            __builtin_amdgcn_fence(__ATOMIC_ACQUIRE, "agent");
            asm volatile("s_waitcnt vmcnt(0)" ::: "memory");
        }
    }
    __syncthreads();
}

#ifndef REP_SYNC
#define REP_SYNC 1
#endif
#ifndef REP_SCAN
#define REP_SCAN 1
#endif
#ifndef REP_F1
#define REP_F1 1
#endif
#ifndef REP_SPAT
#define REP_SPAT 1
#endif
#ifndef REP_MIX
#define REP_MIX 1
#endif
#ifndef REP_R1
#define REP_R1 1
#endif
#ifndef REP_G1
#define REP_G1 1
#endif
#ifndef REP_CONV
#define REP_CONV 1
#endif
#ifndef REP_EA
#define REP_EA 1
#endif
constexpr int XB_LDS_OFF = LDS_BYTES - 16;
#define GS() do { for (int r_ = 0; r_ < REP_SYNC; ++r_) { XcdBarrier xb_; xb_.bar = (unsigned*)WSB(0); xb_.x = xb_xcc_id(); xb_.st = (volatile LAS unsigned*)(lds + XB_LDS_OFF); xcd_barrier(xb_, pg8::otid(wv) == 0); } } while (0)
#define REPEAT(n) for (int r_ = 0; r_ < (n); ++r_)
__global__ void __launch_bounds__(512, 2) mega_fwd(Args a) {
    extern __shared__ __attribute__((aligned(16))) unsigned char lds_raw[];
    LAS unsigned char* lds = (LAS unsigned char*)lds_raw;
    cg::grid_group grid = cg::this_grid();
    const int wv = __builtin_amdgcn_readfirstlane((int)(threadIdx.x >> 6));

    { const int tid = pg8::otid(wv);
      if (pg8::obid() == 0) { unsigned* bw = (unsigned*)WSB(0); for (int i = tid; i < XCD_BAR_WORDS; i += 512) bw[i] = 0u; }
      if (tid < 2) ((volatile LAS unsigned*)(lds + XB_LDS_OFF))[tid] = 0u;
      __syncthreads(); }
    conv_layer(wv, 0, lds);
    ph_init_rows(wv, argp(0), HPTR, WSBF(WS_HB));
    grid.sync();
    (void)xcd_barrier_post((unsigned*)WSB(0), (volatile LAS unsigned*)(lds + XB_LDS_OFF), pg8::otid(wv) == 0);

#pragma unroll 1
    for (int layer = 0; layer < 4; ++layer) {
        const int j = layer >> 1;
        if ((layer & 1) == 0) {
            REPEAT(REP_G1) run_gemm<OpGelu, true>(wv, lds, WSBF(WS_HB), WSBF(WS_W + W_WIN), T, 2048, D, OpGelu{WSBF(WS_P)});
            GS();
            REPEAT(REP_SPAT) ph_spatial(wv, lds, WSBF(WS_P), WSBF(WS_P + 128 * MiB), WSBF(WS_W + W_WSC), argp(8) + j * D, argp(9) + j * D, argp(11) + j * 8 * 128);
            GS();
            run_gemm<OpResidB, true>(wv, lds, WSBF(WS_P + 128 * MiB), WSBF(WS_W + W_WOUT), T, D, D, OpResidB{WSBF(WS_HB)});
            GS();
        } else {
            const size_t offV = j ? P_S1 : WS_VF, offY = j ? WS_VF : P_S1;
#pragma unroll 1
            for (int q = 0; q < 4; ++q) {
                ph_mixprep(wv, WSBF(WS_HB), WSBF(P_S2), argp(13) + (size_t)j * 6 * D, q);
                GS();
                run_gemm<OpR1, true>(wv, lds, WSBF(P_S2), WSBF(WS_W + W_STK), 8192, (j ? 16 : 15) * 256, D, OpR1{RBUF, WSBF(P_S0), WSBF(offV), WSBF(P_LW), WSBF(P_LA), WSBF(P_LG), WSBF(P_LV)}, q * 8192, 0x3541333322220000ll, 32);
                GS();
            }
            if (j) run_gemm<OpVupd, true>(wv, lds, WSBF(P_LV), WSBF(WS_W + W_LV2), T, D, 128, OpVupd{WSBF(offV), WSBF(WS_VF), argp(29) + (size_t)(j - 1) * D});
            REPEAT(REP_EA) run_gemm<OpE, true>(wv, lds, WSBF(P_LW), WSBF(WS_W + W_LW2), T, D, 128, OpE{WSBF(P_S3), argp(15) + (size_t)j * D});
            run_gemm<OpA, true>(wv, lds, WSBF(P_LA), WSBF(WS_W + W_LA2), T, D, 128, OpA{WSBF(P_S2), argp(18) + (size_t)j * D});
            GS();
            REPEAT(REP_SCAN) ph_scan(wv, lds, RBUF, WSBF(P_S0), WSBF(offV), WSBF(P_S2), WSBF(P_S3), WSBF(offY), argp(23) + (size_t)j * D, argp(24) + (size_t)j * D);
            GS();
            ph_post(wv, WSBF(offY), RBUF, WSBF(P_S0), WSBF(offV), WSBF(P_S2), argp(24) + (size_t)j * D, argp(25) + (size_t)j * D, argp(26) + (size_t)j * D, argp(27) + (size_t)j * D);
            GS();
            run_gemm<OpG, true>(wv, lds, WSBF(P_LG), WSBF(WS_W + W_LG2), T, D, 256, OpG{WSBF(P_S3), WSBF(offY)});
            GS();
            run_gemm<OpResidB, true>(wv, lds, WSBF(P_S3), WSBF(WS_W + W_WO), T, D, D, OpResidB{WSBF(WS_HB)});
            GS();
        }
        ph_ln(wv, HPTR, WSBF(WS_HB), argp(1) + (size_t)layer * D, argp(2) + (size_t)layer * D, false, false, true);
        GS();
        REPEAT(REP_F1) run_gemm<OpRelu2, true>(wv, lds, WSBF(WS_HB), WSBF(WS_W + W_W1), T, FF, D, OpRelu2{WSBF(WS_P)});
        GS();
        if (layer < 3) run_gemm<OpResidB, true>(wv, lds, WSBF(WS_P), WSBF(WS_W + W_W2), T, D, FF, OpResidB{WSBF(WS_HB)});
        else run_gemm<OpResidF, true>(wv, lds, WSBF(WS_P), WSBF(WS_W + W_W2), T, D, FF, OpResidF{HPTR, WSBF(WS_HB)});
        GS();
        ph_ln(wv, HPTR, WSBF(WS_HB), argp(3) + (size_t)layer * D, argp(4) + (size_t)layer * D, layer == 3, layer == 3, layer != 3);
        if (layer < 3) REPEAT(REP_CONV) conv_layer(wv, layer + 1, lds);
        GS();
    }
}

extern "C" void kernel_launch(void* const* d_in, const int* in_sizes, int n_in, void* d_out, int out_size, void* d_ws, size_t ws_size, hipStream_t stream) {
    static int grid = 0;
    if (grid == 0) {
        int dev = 0, cus = 0, per_cu = 0;
        hipGetDevice(&dev);
        hipDeviceGetAttribute(&cus, hipDeviceAttributeMultiprocessorCount, dev);
        hipFuncSetAttribute((const void*)mega_fwd, hipFuncAttributeMaxDynamicSharedMemorySize, LDS_BYTES);
        hipOccupancyMaxActiveBlocksPerMultiprocessor(&per_cu, (const void*)mega_fwd, 512, LDS_BYTES);
        (void)hipGetLastError();
        if (per_cu < 1) per_cu = 1;
        if (cus < 1) cus = 256;
        grid = cus * per_cu;
        if (n_in != 32 || ws_size < 512 * MiB) fprintf(stderr, "kernel_launch: unexpected n_in %d / ws_size %zu\n", n_in, ws_size);
    }
    Args a{};
    for (int i = 0; i < 32; ++i) a.in[i] = (const float*)d_in[i];
    a.out = (float*)d_out; a.ws = (unsigned char*)d_ws;
    void* args[] = {&a};
    hipError_t e = hipLaunchCooperativeKernel((const void*)mega_fwd, dim3(grid), dim3(512), args, LDS_BYTES, stream);
    if (e != hipSuccess) fprintf(stderr, "cooperative launch failed: %s (grid %d)\n", hipGetErrorString(e), grid);
}
```
